# Optimizing an MI355X kernel written in HIP

```python
import jax, jax.numpy as jnp
from jax import lax
import numpy as np

D_MODEL = 2048
BATCH = 1
SEQ = 8192
DEPTH = 1

HEAD_DIM = 64
ATTN_Q_HEADS = 16
ATTN_KV_HEADS = 4
ATTN_GROUP = ATTN_Q_HEADS // ATTN_KV_HEADS
WINDOW = 128
ROPE_THETA = 10000.0
MLSTM_HEADS = 4
MLSTM_HEAD_DIM = 256
MLSTM_CHUNK = 64
CONV_WIDTH = 4
ATTN_WIDTH = ATTN_Q_HEADS * HEAD_DIM
KV_WIDTH = ATTN_KV_HEADS * HEAD_DIM
MLSTM_WIDTH = MLSTM_HEADS * MLSTM_HEAD_DIM
MIX_WIDTH = ATTN_WIDTH + MLSTM_WIDTH
IN_WIDTH = ATTN_WIDTH + 2 * KV_WIDTH + 4 * MLSTM_WIDTH + 2 * MLSTM_HEADS
N_GROUPS = 8
EXPERTS_PER_GROUP = 8
N_EXPERTS = N_GROUPS * EXPERTS_PER_GROUP
TOP_K = 2
D_EXPERT = 512
MOE_BLOCK = 128
NORM_EPS = 1e-6

kernel_name = "hymba_swa_mlstm_hmoe_sandwich_adaln"


def rmsnorm(x, g):
    xf = x.astype(jnp.float32)
    y = xf * lax.rsqrt(jnp.mean(xf * xf, axis=-1, keepdims=True) + NORM_EPS)
    return (y * g.astype(jnp.float32)).astype(x.dtype)


def rope_tables(seq):
    pos = jnp.arange(seq, dtype=jnp.float32)
    inv = ROPE_THETA ** (-jnp.arange(0, HEAD_DIM, 2, dtype=jnp.float32) / HEAD_DIM)
    ang = pos[:, None] * inv[None, :]
    return jnp.cos(ang), jnp.sin(ang)


def apply_rope(t, cos, sin):
    tf = t.astype(jnp.float32)
    t1, t2 = jnp.split(tf, 2, axis=-1)
    c = cos[None, :, None, :]
    s = sin[None, :, None, :]
    return jnp.concatenate([t1 * c - t2 * s, t2 * c + t1 * s], axis=-1).astype(t.dtype)


def causal_depthwise_conv(x, w, b):
    S = x.shape[1]
    xp = jnp.pad(x, ((0, 0), (CONV_WIDTH - 1, 0), (0, 0)))
    y = b
    for j in range(CONV_WIDTH):
        y = y + xp[:, j:j + S] * w[j]
    return y


def swa_sink_attention(q, k, v, sinks):
    B, S, H, d = q.shape
    W = WINDOW
    NB = S // W
    qb = q.reshape(B, NB, W, ATTN_KV_HEADS, ATTN_GROUP, d)
    kb = k.reshape(B, NB, W, ATTN_KV_HEADS, d)
    vb = v.reshape(B, NB, W, ATTN_KV_HEADS, d)
    shift = lambda t: jnp.concatenate([jnp.zeros_like(t[:, :1]), t[:, :-1]], axis=1)
    kc = jnp.concatenate([shift(kb), kb], axis=2)
    vc = jnp.concatenate([shift(vb), vb], axis=2)
    s = jnp.einsum('bnqkgd,bnskd->bnkgqs', qb, kc).astype(jnp.float32) * (d ** -0.5)
    i = jnp.arange(W)[:, None]
    j = jnp.arange(2 * W)[None, :]
    rel = W + i - j
    band = (rel >= 0) & (rel < W)
    valid = band[None] & ((jnp.arange(NB)[:, None, None] * W + j[None] - W) >= 0)
    s = jnp.where(valid[None, :, None, None], s, -jnp.inf)
    sk = sinks.astype(jnp.float32).reshape(ATTN_KV_HEADS, ATTN_GROUP)[None, None, :, :, None]
    m = jnp.maximum(s.max(-1), sk)
    p = jnp.exp(s - m[..., None])
    den = p.sum(-1) + jnp.exp(sk - m)
    o = jnp.einsum('bnkgqs,bnskd->bnkgqd', p, vc.astype(jnp.float32)) / den[..., None]
    o = jnp.transpose(o, (0, 1, 4, 2, 3, 5)).reshape(B, S, H * d)
    return o.astype(q.dtype)


def mlstm_chunkwise(q, k, v, ig, fg):
    B, S, H, dk = q.shape
    dv = v.shape[-1]
    L = MLSTM_CHUNK
    NC = S // L
    chunks = lambda t: jnp.moveaxis(t.reshape((B, NC, L, H) + t.shape[3:]), 3, 1)
    q = chunks(q.astype(jnp.float32))
    k = chunks(k.astype(jnp.float32)) * (dk ** -0.5)
    v = chunks(v.astype(jnp.float32))
    ig = chunks(ig)
    logf = chunks(jax.nn.log_sigmoid(fg))
    b = jnp.cumsum(logf, axis=-1)
    b_last = b[..., -1]
    a = b_last[..., None] - b + ig
    m_loc = a.max(-1)
    wk = jnp.exp(a - m_loc[..., None])
    kv_c = jnp.einsum('bhcl,bhcle,bhcld->bhced', wk, v, k)
    k_c = jnp.einsum('bhcl,bhcld->bhcd', wk, k)

    def step(carry, xs):
        C, n, m = carry
        kv, kk, bl, ml = xs
        m_new = jnp.maximum(bl + m, ml)
        a_old = jnp.exp(bl + m - m_new)
        a_new = jnp.exp(ml - m_new)
        C_new = a_old[..., None, None] * C + a_new[..., None, None] * kv
        n_new = a_old[..., None] * n + a_new[..., None] * kk
        return (C_new, n_new, m_new), (C, n, m)

    init = (jnp.zeros((B, H, dv, dk), jnp.float32), jnp.zeros((B, H, dk), jnp.float32),
            jnp.zeros((B, H), jnp.float32))
    xs = (jnp.moveaxis(kv_c, 2, 0), jnp.moveaxis(k_c, 2, 0),
          jnp.moveaxis(b_last, 2, 0), jnp.moveaxis(m_loc, 2, 0))
    _, (C_prev, n_prev, m_prev) = lax.scan(step, init, xs)
    C_prev = jnp.moveaxis(C_prev, 0, 2)
    n_prev = jnp.moveaxis(n_prev, 0, 2)
    m_prev = jnp.moveaxis(m_prev, 0, 2)

    causal = jnp.tril(jnp.ones((L, L), dtype=bool))
    Dlog = jnp.where(causal, b[..., :, None] - b[..., None, :] + ig[..., None, :], -jnp.inf)
    g = b + m_prev[..., None]
    m_t = jnp.maximum(g, Dlog.max(-1))
    P = jnp.exp(Dlog - m_t[..., None])
    inter = jnp.exp(g - m_t)
    Sw = P * jnp.einsum('bhcld,bhcsd->bhcls', q, k)
    num = jnp.einsum('bhcls,bhcse->bhcle', Sw, v) + inter[..., None] * jnp.einsum('bhcld,bhced->bhcle', q, C_prev)
    den = Sw.sum(-1) + inter * jnp.einsum('bhcld,bhcd->bhcl', q, n_prev)
    h = num / jnp.maximum(jnp.abs(den), jnp.exp(-m_t))[..., None]
    return jnp.moveaxis(h, 1, 3).reshape(B, S, H, dv)


def hybrid_mixer(h, w_in, b_gates, conv_w, conv_b, sinks, mnorm, w_out, cos, sin):
    B, S, _ = h.shape
    z = h @ w_in
    cuts = np.cumsum([ATTN_WIDTH, KV_WIDTH, KV_WIDTH, MLSTM_WIDTH, MLSTM_WIDTH, MLSTM_WIDTH, MLSTM_WIDTH]).tolist()
    aq, ak, av, mq, mk, mv, mo, mif = jnp.split(z, cuts, axis=-1)
    aq = apply_rope(aq.reshape(B, S, ATTN_Q_HEADS, HEAD_DIM), cos, sin)
    ak = apply_rope(ak.reshape(B, S, ATTN_KV_HEADS, HEAD_DIM), cos, sin)
    av = av.reshape(B, S, ATTN_KV_HEADS, HEAD_DIM)
    y_attn = swa_sink_attention(aq, ak, av, sinks)
    qk = jax.nn.silu(causal_depthwise_conv(jnp.concatenate([mq, mk], axis=-1), conv_w, conv_b))
    mq, mk = jnp.split(qk, 2, axis=-1)
    gates = mif.astype(jnp.float32) + b_gates.astype(jnp.float32)
    ig, fg = gates[..., :MLSTM_HEADS], gates[..., MLSTM_HEADS:]
    hm = mlstm_chunkwise(mq.reshape(B, S, MLSTM_HEADS, MLSTM_HEAD_DIM),
                         mk.reshape(B, S, MLSTM_HEADS, MLSTM_HEAD_DIM),
                         mv.reshape(B, S, MLSTM_HEADS, MLSTM_HEAD_DIM), ig, fg)
    hm = hm * lax.rsqrt(jnp.mean(hm * hm, axis=-1, keepdims=True) + NORM_EPS)
    hm = hm * mnorm.astype(jnp.float32).reshape(MLSTM_HEADS, MLSTM_HEAD_DIM)
    y_mlstm = (jax.nn.sigmoid(mo.astype(jnp.float32)) * hm.reshape(B, S, MLSTM_WIDTH)).astype(h.dtype)
    return jnp.concatenate([y_attn, y_mlstm], axis=-1) @ w_out


def hierarchical_moe(h, w_group, b_group, w_expert, b_expert, w1, w3, w2):
    B, S, D = h.shape
    T = B * S
    xt = h.reshape(T, D)
    g_logits = (xt @ w_group).astype(jnp.float32) + b_group.astype(jnp.float32)
    g_idx = jnp.argmax(g_logits, axis=-1)
    g_prob = jnp.take_along_axis(jax.nn.softmax(g_logits, axis=-1), g_idx[:, None], axis=1)
    e_logits = ((xt @ w_expert).astype(jnp.float32) + b_expert.astype(jnp.float32)).reshape(T, N_GROUPS, EXPERTS_PER_GROUP)
    e_logits = jnp.take_along_axis(e_logits, g_idx[:, None, None], axis=1)[:, 0]
    top_v, top_i = lax.top_k(e_logits, TOP_K)
    weights = g_prob * jax.nn.softmax(top_v, axis=-1)
    experts = g_idx[:, None] * EXPERTS_PER_GROUP + top_i
    A = T * TOP_K
    e_flat = experts.reshape(A)
    tok_flat = jnp.repeat(jnp.arange(T, dtype=jnp.int32), TOP_K)
    w_flat = weights.reshape(A)
    order = jnp.argsort(e_flat, stable=True)
    e_sorted = e_flat[order]
    tok_sorted = tok_flat[order]
    w_sorted = w_flat[order]
    counts = jnp.bincount(e_flat, length=N_EXPERTS)
    starts = jnp.cumsum(counts) - counts
    padded = ((counts + MOE_BLOCK - 1) // MOE_BLOCK) * MOE_BLOCK
    pend = jnp.cumsum(padded)
    pstarts = pend - padded
    dest = pstarts[e_sorted] + (jnp.arange(A) - starts[e_sorted])
    n_blocks = -(-A // MOE_BLOCK) + N_EXPERTS
    P = n_blocks * MOE_BLOCK
    row_tok = jnp.zeros((P,), jnp.int32).at[dest].set(tok_sorted)
    block_e = jnp.minimum(jnp.searchsorted(pend, jnp.arange(n_blocks) * MOE_BLOCK, side='right'), N_EXPERTS - 1)
    xb = xt[row_tok].reshape(n_blocks, MOE_BLOCK, D)

    def run_block(args):
        xblk, e = args
        return (jax.nn.silu(xblk @ w1[e]) * (xblk @ w3[e])) @ w2[e]

    yb = lax.map(run_block, (xb, block_e)).reshape(P, D)
    y_assign = yb[dest].astype(jnp.float32) * w_sorted[:, None]
    out = jnp.zeros((T, D), jnp.float32).at[tok_sorted].add(y_assign)
    return out.astype(h.dtype).reshape(B, S, D)


def setup_inputs(seed: int = 0) -> dict:
    key = jax.random.key(seed)
    ks = jax.random.split(key, 24)
    f32 = jnp.float32
    nrm = lambda k, shape, scale: jax.random.normal(k, shape, f32) * scale
    L_, D = DEPTH, D_MODEL
    f_bias = jnp.broadcast_to(jnp.linspace(3.0, 6.0, MLSTM_HEADS, dtype=f32), (L_, MLSTM_HEADS))
    b_gates = jnp.concatenate([nrm(ks[9], (L_, MLSTM_HEADS), 0.1),
                               f_bias + nrm(ks[10], (L_, MLSTM_HEADS), 0.1)], axis=-1)
    return {
        "x": nrm(ks[0], (BATCH, SEQ, D), 1.0),
        "c": nrm(ks[1], (BATCH, D), 1.0),
        "w_ada": nrm(ks[2], (L_, D, 6 * D), 0.5 * D ** -0.5),
        "b_ada": nrm(ks[3], (L_, 6 * D), 0.02),
        "g_pre_mix": 1.0 + nrm(ks[4], (L_, D), 0.05),
        "g_post_mix": 1.0 + nrm(ks[5], (L_, D), 0.05),
        "g_pre_ffn": 1.0 + nrm(ks[6], (L_, D), 0.05),
        "g_post_ffn": 1.0 + nrm(ks[7], (L_, D), 0.05),
        "w_in": nrm(ks[8], (L_, D, IN_WIDTH), D ** -0.5),
        "b_gates": b_gates,
        "conv_w": nrm(ks[11], (L_, CONV_WIDTH, 2 * MLSTM_WIDTH), CONV_WIDTH ** -0.5),
        "conv_b": nrm(ks[12], (L_, 2 * MLSTM_WIDTH), 0.02),
        "attn_sinks": nrm(ks[13], (L_, ATTN_Q_HEADS), 0.5),
        "mlstm_norm": 1.0 + nrm(ks[14], (L_, MLSTM_WIDTH), 0.05),
        "w_out": nrm(ks[15], (L_, MIX_WIDTH, D), MIX_WIDTH ** -0.5),
        "w_group": nrm(ks[16], (L_, D, N_GROUPS), D ** -0.5),
        "b_group": nrm(ks[17], (L_, N_GROUPS), 0.01),
        "w_expert": nrm(ks[18], (L_, D, N_EXPERTS), D ** -0.5),
        "b_expert": nrm(ks[19], (L_, N_EXPERTS), 0.01),
        "w1": nrm(ks[20], (L_, N_EXPERTS, D, D_EXPERT), D ** -0.5),
        "w3": nrm(ks[21], (L_, N_EXPERTS, D, D_EXPERT), D ** -0.5),
        "w2": nrm(ks[22], (L_, N_EXPERTS, D_EXPERT, D), D_EXPERT ** -0.5),
    }


def reference(x, c, w_ada, b_ada, g_pre_mix, g_post_mix, g_pre_ffn, g_post_ffn, w_in, b_gates,
              conv_w, conv_b, attn_sinks, mlstm_norm, w_out, w_group, b_group, w_expert, b_expert,
              w1, w3, w2):
    B, S, D = x.shape
    cos, sin = rope_tables(S)
    for l in range(DEPTH):
        mod = (jax.nn.silu(c) @ w_ada[l] + b_ada[l]).reshape(B, 6, D)[:, :, None, :]
        shift1, scale1, gate1, shift2, scale2, gate2 = [mod[:, i] for i in range(6)]
        h = rmsnorm(x, g_pre_mix[l]) * (1.0 + scale1) + shift1
        y = hybrid_mixer(h, w_in[l], b_gates[l], conv_w[l], conv_b[l], attn_sinks[l],
                         mlstm_norm[l], w_out[l], cos, sin)
        x = x + gate1 * rmsnorm(y, g_post_mix[l])
        h = rmsnorm(x, g_pre_ffn[l]) * (1.0 + scale2) + shift2
        y = hierarchical_moe(h, w_group[l], b_group[l], w_expert[l], b_expert[l], w1[l], w3[l], w2[l])
        x = x + gate2 * rmsnorm(y, g_post_ffn[l])
    return x
```

```cpp
#include <hip/hip_runtime.h>
#include <cstdio>
#include <cstdint>
namespace pg8 {
#define PG8_LAS __attribute__((address_space(3)))
typedef unsigned short bf16_t;
typedef short bf16x8 __attribute__((ext_vector_type(8)));
typedef float f32x4 __attribute__((ext_vector_type(4)));
typedef unsigned u32x4 __attribute__((ext_vector_type(4)));
constexpr int BM = 256, BK = 64, HALF = 128, HTB = HALF * BK * 2  , STAGE_BYTES = 8 * HTB, NXCD = 8, WGM = 8;

__host__ __device__ __forceinline__ int lds_byte(int r, int c) { const int st = (r >> 4) * 2 + (c >> 5), rr = r & 15, cc = c & 31, ob = rr * 64 + cc * 2; return st * 1024 + (ob ^ (((ob >> 9) & 1) << 5)); }
__host__ __device__ __forceinline__ void stage_rc(int b, int& R, int& C) { const int st = b / 1024, sb = b % 1024, swz = sb ^ (((sb >> 9) & 1) << 5); R = (st >> 1) * 16 + swz / 64; C = (st & 1) * 32 + (swz % 64) / 2; }
__host__ __device__ __forceinline__ int perm32(int rho) { const int n = rho >> 4, i = rho & 15; return 8 * (i >> 2) + 4 * n + (i & 3); }

__device__ __forceinline__ unsigned cvt_pk_bf16(float lo, float hi) { unsigned r; asm volatile("v_cvt_pk_bf16_f32 %0, %1, %2" : "=v"(r) : "v"(lo), "v"(hi)); return r; }
struct Unit { int pm, pn; };
struct Gemm { const bf16_t* A; const bf16_t* Bt; int M, N, K; };

struct StaticOrder {
    int nM, nN, nwg, G, c;
    __host__ __device__ void init(int M, int N, int G_, int c_) { nM = M / BM; nN = N / BM; nwg = nM * nN; G = G_; c = c_; }
    __host__ __device__ bool next(int i, Unit& u) const {
        const long L = (long)i * G + c; if (L >= nwg) return false;
        int wgid = (int)L; { const int q = nwg / NXCD, r = nwg % NXCD, xcd = wgid % NXCD, off = wgid / NXCD; wgid = (xcd < r ? xcd * (q + 1) : r * (q + 1) + (xcd - r) * q) + off; }
        const int nig = WGM * nN, gid = wgid / nig, fm = gid * WGM, gsz = (nM - fm) < WGM ? (nM - fm) : WGM;
        u.pm = fm + ((wgid % nig) % gsz); u.pn = (wgid % nig) / gsz; return true;
    }
    __device__ __forceinline__ void a_ready(const Unit&) const {}
    __device__ __forceinline__ void done(const Unit&) const {}
};

template <class Epi, class Sched, bool ALIGN_EPI = false, bool SP2 = false>
__device__ __forceinline__ void gemm_phase(PG8_LAS unsigned char* lds, const Gemm g, const Sched& S, const Epi& E) {
    const int tid = threadIdx.x, wid = __builtin_amdgcn_readfirstlane(tid >> 6), lane = tid & 63, wr = wid >> 2, wc = wid & 3, fr = lane & 15, fq = lane >> 4;
    const int K = g.K, nt = K / BK;
    unsigned voffA[2], voffB[2];
#pragma unroll
    for (int i = 0; i < 2; ++i) { int R, C; stage_rc(tid * 16 + i * 8192, R, C); const int Rb = Epi::PERM ? ((R & ~31) + perm32(R & 31)) : R;
        voffA[i] = (unsigned)(R * K + C) * 2u; voffB[i] = (unsigned)(Rb * K + C) * 2u; }
    const size_t kstep = (size_t)(BK * 2);
    const size_t hstep = (size_t)HALF * K * 2;
    const size_t tstep = 2 * hstep;
    const unsigned ldsw = (unsigned)wid * 1024u;
    const int aoff = lds_byte(wr * 64 + fr, fq * 8), boff = lds_byte(wc * 32 + fr, fq * 8);
#define PG8_SA(b, h) (((b) * 2 + (h)) * HTB)
#define PG8_SB(b, h) ((4 + (b) * 2 + (h)) * HTB)
#define PG8_STAGE(bufoff, gbase, voff) do { _Pragma("unroll") for (int _i = 0; _i < 2; ++_i) \
        __builtin_amdgcn_global_load_lds((const unsigned*)((const char*)(gbase) + (voff)[_i]), (PG8_LAS unsigned*)(lds + (bufoff) + ldsw + _i * 8192), 16, 0, 0); } while (0)
#define PG8_LDA(dst, b, h) do { _Pragma("unroll") for (int m = 0; m < 4; ++m) _Pragma("unroll") for (int k = 0; k < 2; ++k) dst[m][k] = *(const PG8_LAS bf16x8*)(lds + PG8_SA(b, h) + aoff + m * 2048 + k * 1024); } while (0)
#define PG8_LDB(dst, b, h) do { _Pragma("unroll") for (int n = 0; n < 2; ++n) _Pragma("unroll") for (int k = 0; k < 2; ++k) dst[n][k] = *(const PG8_LAS bf16x8*)(lds + PG8_SB(b, h) + boff + n * 2048 + k * 1024); } while (0)
#define PG8_MMA(ai, bj, At, Bt) do { __builtin_amdgcn_s_setprio(1); _Pragma("unroll") for (int m = 0; m < 4; ++m) _Pragma("unroll") for (int n = 0; n < 2; ++n) _Pragma("unroll") for (int k = 0; k < 2; ++k) \
        acc[ai][bj][m][n] = __builtin_amdgcn_mfma_f32_16x16x32_bf16(Bt[n][k], At[m][k], acc[ai][bj][m][n], 0, 0, 0); __builtin_amdgcn_s_setprio(0); } while (0)
#define PG8_WAIT_V(n) asm volatile("s_waitcnt vmcnt(" #n ")" ::: "memory")
#define PG8_WAIT_L(n) asm volatile("s_waitcnt lgkmcnt(" #n ")" ::: "memory")
#define PG8_BAR __builtin_amdgcn_s_barrier()
#define PG8_SCHED __builtin_amdgcn_sched_barrier(0)
    Unit cur, nxt; int ui = 0;
    if (!S.next(0, cur)) return;
    f32x4 acc[2][2][4][2];
#pragma unroll
    for (int a = 0; a < 2; ++a)
#pragma unroll
        for (int b = 0; b < 2; ++b)
#pragma unroll
            for (int m = 0; m < 4; ++m)
#pragma unroll
                for (int n = 0; n < 2; ++n) acc[a][b][m][n] = (f32x4){0.f, 0.f, 0.f, 0.f};
    bf16x8 At[4][2], B0[2][2], B1[2][2];
    const char* cA = (const char*)g.A + (size_t)cur.pm * tstep; const char* cB = (const char*)g.Bt + (size_t)cur.pn * tstep;
    S.a_ready(cur);
    if constexpr (SP2) {
        PG8_STAGE(PG8_SB(0, 0), cB, voffB); PG8_STAGE(PG8_SB(0, 1), cB + hstep, voffB); PG8_STAGE(PG8_SA(0, 0), cA, voffA); PG8_STAGE(PG8_SA(0, 1), cA + hstep, voffA);
        if (wr == 1) PG8_BAR;
        PG8_WAIT_V(2); PG8_BAR;
        PG8_STAGE(PG8_SB(1, 0), cB + kstep, voffB); PG8_STAGE(PG8_SA(1, 0), cA + kstep, voffA); PG8_STAGE(PG8_SB(1, 1), cB + hstep + kstep, voffB);
        PG8_WAIT_V(6); PG8_BAR;
    } else {
        PG8_STAGE(PG8_SB(0, 0), cB, voffB); PG8_STAGE(PG8_SA(0, 0), cA, voffA); PG8_STAGE(PG8_SB(0, 1), cB + hstep, voffB); PG8_STAGE(PG8_SA(0, 1), cA + hstep, voffA);
        if (wr == 1) PG8_BAR;
        PG8_WAIT_V(4); PG8_BAR;
        PG8_STAGE(PG8_SB(1, 0), cB + kstep, voffB); PG8_STAGE(PG8_SA(1, 0), cA + kstep, voffA); PG8_STAGE(PG8_SB(1, 1), cB + hstep + kstep, voffB);
        PG8_WAIT_V(6); PG8_BAR;
    }
    for (;;) {
        const bool has_next = S.next(ui + 1, nxt);
        const char* nA = has_next ? (const char*)g.A + (size_t)nxt.pm * tstep : cA; const char* nB = has_next ? (const char*)g.Bt + (size_t)nxt.pn * tstep : cB;
        for (int t = 0; t < nt; t += 2) {
            const bool last = (t == nt - 2);
            const char* a1 = cA + (size_t)(t + 1) * kstep;
            const char* a2 = last ? nA : cA + (size_t)(t + 2) * kstep; const char* b2 = last ? nB : cB + (size_t)(t + 2) * kstep;
            const char* a3 = a2 + kstep; const char* b3 = b2 + kstep;
            if (last && has_next) S.a_ready(nxt);
            if constexpr (SP2) {
            PG8_LDB(B0, 0, 0); PG8_LDB(B1, 0, 1); PG8_SCHED; PG8_LDA(At, 0, 0); PG8_STAGE(PG8_SA(1, 1), a1 + hstep, voffA);
            PG8_WAIT_V(8); PG8_WAIT_L(0); PG8_BAR; PG8_MMA(0, 0, At, B0); PG8_MMA(0, 1, At, B1); PG8_BAR; PG8_SCHED;
            PG8_LDA(At, 0, 1); PG8_STAGE(PG8_SB(0, 0), b2, voffB); PG8_STAGE(PG8_SB(0, 1), b2 + hstep, voffB); PG8_STAGE(PG8_SA(0, 0), a2, voffA);
            PG8_WAIT_V(8); PG8_WAIT_L(0); PG8_BAR; PG8_MMA(1, 0, At, B0); PG8_MMA(1, 1, At, B1); PG8_BAR; PG8_SCHED;
            PG8_LDB(B0, 1, 0); PG8_LDB(B1, 1, 1); PG8_SCHED; PG8_LDA(At, 1, 0); PG8_STAGE(PG8_SA(0, 1), a2 + hstep, voffA);
            PG8_WAIT_V(8); PG8_WAIT_L(0); PG8_BAR; PG8_MMA(0, 0, At, B0); PG8_MMA(0, 1, At, B1); PG8_BAR; PG8_SCHED;
            PG8_LDA(At, 1, 1); PG8_STAGE(PG8_SB(1, 0), b3, voffB); PG8_STAGE(PG8_SB(1, 1), b3 + hstep, voffB); PG8_STAGE(PG8_SA(1, 0), a3, voffA);
            PG8_WAIT_V(8); PG8_WAIT_L(0); PG8_BAR; PG8_MMA(1, 0, At, B0); PG8_MMA(1, 1, At, B1); PG8_BAR; PG8_SCHED;
            } else {
            PG8_LDB(B0, 0, 0); PG8_SCHED; PG8_LDA(At, 0, 0); PG8_STAGE(PG8_SA(1, 1), a1 + hstep, voffA);
            PG8_WAIT_L(8); PG8_BAR; PG8_WAIT_L(0); PG8_MMA(0, 0, At, B0); PG8_BAR; PG8_SCHED;
            PG8_LDB(B1, 0, 1); PG8_STAGE(PG8_SB(0, 0), b2, voffB);
            PG8_BAR; PG8_WAIT_L(0); PG8_MMA(0, 1, At, B1); PG8_BAR;
            PG8_LDA(At, 0, 1); PG8_STAGE(PG8_SA(0, 0), a2, voffA);
            PG8_BAR; PG8_WAIT_L(0); PG8_MMA(1, 0, At, B0); PG8_BAR; PG8_SCHED;
            PG8_STAGE(PG8_SB(0, 1), b2 + hstep, voffB);
            PG8_WAIT_V(6); PG8_BAR; PG8_MMA(1, 1, At, B1); PG8_BAR;
            PG8_LDB(B0, 1, 0); PG8_SCHED; PG8_LDA(At, 1, 0); PG8_STAGE(PG8_SA(0, 1), a2 + hstep, voffA);
            PG8_WAIT_L(8); PG8_BAR; PG8_WAIT_L(0); PG8_MMA(0, 0, At, B0); PG8_BAR; PG8_SCHED;
            PG8_LDB(B1, 1, 1); PG8_STAGE(PG8_SB(1, 0), b3, voffB);
            PG8_BAR; PG8_WAIT_L(0); PG8_MMA(0, 1, At, B1); PG8_BAR;
            PG8_LDA(At, 1, 1); PG8_STAGE(PG8_SA(1, 0), a3, voffA);
            PG8_BAR; PG8_WAIT_L(0); PG8_MMA(1, 0, At, B0); PG8_BAR; PG8_SCHED;
            PG8_STAGE(PG8_SB(1, 1), b3 + hstep, voffB);
            PG8_WAIT_V(6); PG8_BAR; PG8_MMA(1, 1, At, B1); PG8_BAR;
            }
        }
        if constexpr (ALIGN_EPI) { if (wr == 0) PG8_BAR; }
        if constexpr (!Epi::AFTER_DRAIN) { E(acc, cur, wr, wc, fr, fq); S.done(cur); }
        if (!has_next) break;
#pragma unroll
        for (int a = 0; a < 2; ++a)
#pragma unroll
            for (int b = 0; b < 2; ++b)
#pragma unroll
                for (int m = 0; m < 4; ++m)
#pragma unroll
                    for (int n = 0; n < 2; ++n) acc[a][b][m][n] = (f32x4){0.f, 0.f, 0.f, 0.f};
        cur = nxt; cA = nA; cB = nB; ++ui;
        if constexpr (ALIGN_EPI) { if (wr == 1) PG8_BAR; }
    }
    PG8_WAIT_V(0);
    if constexpr (!ALIGN_EPI) { if (wr == 0) PG8_BAR; }
    PG8_BAR;
    if constexpr (Epi::AFTER_DRAIN) { E.fused(acc, cur, wr, wc, fr, fq, lds, wid, lane); S.done(cur); }
#undef PG8_SA
#undef PG8_SB
#undef PG8_STAGE
#undef PG8_LDA
#undef PG8_LDB
#undef PG8_MMA
#undef PG8_WAIT_V
#undef PG8_WAIT_L
#undef PG8_BAR
#undef PG8_SCHED
}
}
#define GAS __attribute__((address_space(1)))
#define LAS __attribute__((address_space(3)))
typedef unsigned short bf16;
typedef unsigned v4u __attribute__((ext_vector_type(4)));
typedef unsigned v2u __attribute__((ext_vector_type(2)));
typedef float f32x4 __attribute__((ext_vector_type(4)));
typedef float f32x2 __attribute__((ext_vector_type(2)));
typedef short bf16x8 __attribute__((ext_vector_type(8)));
typedef short s16x4 __attribute__((ext_vector_type(4)));

constexpr int T = 8192, D = 2048, NQW = 1024, NKVW = 256, MW = 1024, INW = 5640, NIN = 5632;
constexpr int NEXP = 64, DE = 512;
constexpr int NWAVES = 8, NTHR = 512;
constexpr float EPS = 1e-6f;
constexpr int LDS_BYTES = 147456;
constexpr size_t MiB = 1u << 20;
constexpr size_t WS_CTL = 0, CTL_ZERO_BYTES = 64 * 1024;
constexpr size_t WS_MODP = 1 * MiB;
constexpr size_t WS_MODP0 = 13 * MiB;
constexpr size_t WS_MODF = 3 * MiB;
constexpr size_t WS_COS = 4 * MiB, WS_SIN = 5 * MiB;
constexpr size_t WS_GATES = 6 * MiB;
constexpr size_t WS_GA = 6 * MiB + 256 * 1024, WS_GB = WS_GA + 128 * 1024, WS_GM = WS_GB + 128 * 1024;
constexpr size_t WS_CS = WS_GM + 128 * 1024;
constexpr size_t WS_DEN = WS_CS + 64 * 1024;
constexpr size_t WS_ROUTE = 7 * MiB;
constexpr size_t WS_WCH = 12 * MiB;
constexpr size_t WS_ABC = 14 * MiB;
constexpr size_t WS_PAN = 11 * MiB;
constexpr size_t WS_HIST = 10 * MiB;
constexpr size_t WS_LISTS = 8 * MiB;
constexpr int LCAP = 8192;
constexpr size_t WS_WINT = 16 * MiB, WS_WOUTT = 38 * MiB, WS_HN = 48 * MiB;
constexpr size_t WS_QA = 80 * MiB, WS_KA = 96 * MiB, WS_VA = 100 * MiB, WS_MQ0 = 104 * MiB, WS_MK0 = 120 * MiB, WS_MV = 136 * MiB, WS_MO = 152 * MiB;
constexpr size_t WS_MQ = 168 * MiB, WS_MK = 184 * MiB, WS_NUM = 200 * MiB, WS_YMIX = 232 * MiB, WS_Y = 264 * MiB, WS_X1 = 328 * MiB;
constexpr size_t WS_XG = 80 * MiB;
constexpr size_t WS_HG = 208 * MiB;
constexpr size_t WS_YA = 392 * MiB;
constexpr size_t WS_W13T = 456 * MiB;
constexpr size_t WS_W2T = 712 * MiB;
constexpr size_t WS_END = 840 * MiB;
constexpr int CW_TMO = 0, CW_BAR = 4096, CW_CNT = 8192  ;

#define RLX_AGENT __ATOMIC_RELAXED, __HIP_MEMORY_SCOPE_AGENT
__device__ __forceinline__ float bf2f(unsigned v) { return __uint_as_float(v << 16); }
typedef float f32x2_t __attribute__((ext_vector_type(2))); typedef __bf16 bf16x2_t __attribute__((ext_vector_type(2)));
__device__ __forceinline__ unsigned pk2(float lo, float hi) { f32x2_t v = {lo, hi}; bf16x2_t b = __builtin_convertvector(v, bf16x2_t); return __builtin_bit_cast(unsigned, b); }
__device__ __forceinline__ v2u pk4(f32x4 v) { v2u r; r.x = pk2(v.x, v.y); r.y = pk2(v.z, v.w); return r; }
__device__ __forceinline__ float wave_sum(float v) {
#pragma unroll
    for (int o = 1; o < 64; o <<= 1) v += __shfl_xor(v, o);
    return v;
}
__device__ __forceinline__ float wave_max(float v) {
#pragma unroll
    for (int o = 1; o < 64; o <<= 1) v = fmaxf(v, __shfl_xor(v, o));
    return v;
}
__device__ __forceinline__ float siluf(float v) { return v / (1.f + __expf(-v)); }
__device__ __forceinline__ float sigmoidf_(float v) { return 1.f / (1.f + __expf(-v)); }
__device__ __forceinline__ bf16x8 cat8(s16x4 a, s16x4 b) { bf16x8 r; r[0] = a[0]; r[1] = a[1]; r[2] = a[2]; r[3] = a[3]; r[4] = b[0]; r[5] = b[1]; r[6] = b[2]; r[7] = b[3]; return r; }
__device__ __forceinline__ s16x4 tr16(const LAS unsigned char* p) { return __builtin_bit_cast(s16x4, __builtin_amdgcn_ds_read_tr16_b64_v4i16((LAS s16x4*)p)); }
__device__ __forceinline__ bf16x8 pack8(f32x4 a, f32x4 b) { v4u r; r.x = pk2(a.x, a.y); r.y = pk2(a.z, a.w); r.z = pk2(b.x, b.y); r.w = pk2(b.z, b.w); return __builtin_bit_cast(bf16x8, r); }
__device__ __forceinline__ float swap1(float x) { return __int_as_float(__builtin_amdgcn_update_dpp(0, __float_as_int(x), 0xB1, 0xF, 0xF, true)); }
#define MFMA16(a, b, c) __builtin_amdgcn_mfma_f32_16x16x32_bf16((a), (b), (c), 0, 0, 0)

__device__ const float ROPE_INV[32] = {1.000000000e+00f, 7.498942018e-01f, 5.623413324e-01f, 4.216965139e-01f, 3.162277639e-01f, 2.371373773e-01f, 1.778279394e-01f, 1.333521456e-01f, 1.000000015e-01f, 7.498942316e-02f, 5.623413250e-02f, 4.216964915e-02f, 3.162277490e-02f, 2.371373773e-02f, 1.778279431e-02f, 1.333521400e-02f, 9.999999776e-03f, 7.498942316e-03f, 5.623413250e-03f, 4.216964822e-03f, 3.162277630e-03f, 2.371373819e-03f, 1.778279431e-03f, 1.333521446e-03f, 1.000000047e-03f, 7.498941850e-04f, 5.623413017e-04f, 4.216965172e-04f, 3.162277571e-04f, 2.371373703e-04f, 1.778279402e-04f, 1.333521504e-04f};

struct Args { const float* in[22]; float* out; unsigned char* ws; int ph_lo, ph_hi; };
enum { I_X = 0, I_C, I_WADA, I_BADA, I_GPREMIX, I_GPOSTMIX, I_GPREFFN, I_GPOSTFFN, I_WIN, I_BGATES, I_CONVW, I_CONVB, I_SINKS, I_MNORM, I_WOUT, I_WGROUP, I_BGROUP, I_WEXPERT, I_BEXPERT, I_W1, I_W3, I_W2 };
#define XBLAS LAS
#define XB_TMO      128
#define XB_XCNT(j)  (256  + 64 * (j))
#define XB_XSUB(j)  (1280 + 64 * (j))
#define XB_XGEN(j)  (2304 + 64 * (j))
#define XB_TOP      3328
#define XB_TOPGEN   3392
#define XCD_BAR_WORDS 3456
#define XB_SPIN_CAP (1u << 18)

__device__ __forceinline__ unsigned xb_ld(unsigned* p)              { return __hip_atomic_load(p, __ATOMIC_RELAXED, __HIP_MEMORY_SCOPE_AGENT); }
__device__ __forceinline__ unsigned xb_add(unsigned* p, unsigned v) { return __hip_atomic_fetch_add(p, v, __ATOMIC_RELAXED, __HIP_MEMORY_SCOPE_AGENT); }
__device__ __forceinline__ unsigned xb_xcc_id() { return (unsigned)__builtin_amdgcn_s_getreg((3 << 11) | 20) & 0xFu; }
#define XB_SPIN(cond, bar) do { unsigned _sp = 0; while (cond) { __builtin_amdgcn_s_sleep(1); \
    if ((++_sp & 255u) == 0u) { if (xb_ld(&(bar)[XB_TMO])) break; if (_sp > XB_SPIN_CAP) { atomicAdd(&(bar)[XB_TMO], 1u); break; } } } } while (0)

struct XcdBarrier {
    unsigned* bar; unsigned x;
    volatile LAS unsigned* st;
};

__device__ __forceinline__ XcdBarrier xcd_barrier_post(unsigned* bar, volatile LAS unsigned* st) {
    XcdBarrier b; b.bar = bar; b.x = xb_xcc_id(); b.st = st;
    if (threadIdx.x == 0) (void)xb_add(&bar[XB_XCNT(b.x)], 1u);
    return b;
}
__device__ __forceinline__ void xcd_barrier_complete(unsigned* bar, unsigned x, unsigned& nloc, unsigned& nx) {
    const unsigned G = gridDim.x * gridDim.y * gridDim.z;
    unsigned sum, cnt, mine, sp = 0u;
    for (;;) {
        sum = 0u; cnt = 0u; mine = 0u;
#pragma unroll
        for (unsigned j = 0; j < 16; ++j) { const unsigned c = xb_ld(&bar[XB_XCNT(j)]); sum += c; cnt += (c > 0u) ? 1u : 0u; mine = (j == x) ? c : mine; }
        if (sum == G) break;
        __builtin_amdgcn_s_sleep(1);
        if ((++sp & 255u) == 0u) { if (xb_ld(&bar[XB_TMO])) break; if (sp > XB_SPIN_CAP) { atomicAdd(&bar[XB_TMO], 1u); break; } }
    }
    nloc = mine > 0u ? mine : 1u; nx = cnt > 0u ? cnt : 1u;
}

__device__ __forceinline__ void xcd_barrier(const XcdBarrier& b) {
    asm volatile("s_waitcnt vmcnt(0)" ::: "memory");
    __syncthreads();
    if (threadIdx.x == 0) {
        unsigned* bar = b.bar;
        __builtin_amdgcn_s_waitcnt(0);
        unsigned nloc = b.st[0], nx = b.st[1];
        if (nloc == 0u) { xcd_barrier_complete(bar, b.x, nloc, nx); b.st[0] = nloc; b.st[1] = nx; }
        const unsigned old = xb_add(&bar[XB_XSUB(b.x)], 1u);
        const unsigned gen = old / nloc;
        if (old + 1u == (gen + 1u) * nloc) {
            __builtin_amdgcn_fence(__ATOMIC_RELEASE, "agent");
            asm volatile("s_waitcnt vmcnt(0)" ::: "memory");
            const unsigned og = xb_add(&bar[XB_TOP], 1u);
            const unsigned tg = og / nx;
            if (og + 1u == (tg + 1u) * nx) xb_add(&bar[XB_TOPGEN], 1u);
            else XB_SPIN(xb_ld(&bar[XB_TOPGEN]) == tg, bar);
            __builtin_amdgcn_fence(__ATOMIC_ACQUIRE, "agent");
            xb_add(&bar[XB_XGEN(b.x)], 1u);
            asm volatile("s_waitcnt vmcnt(0)" ::: "memory");
        } else {
            XB_SPIN(xb_ld(&bar[XB_XGEN(b.x)]) == gen, bar);
            __builtin_amdgcn_fence(__ATOMIC_ACQUIRE, "agent");
            asm volatile("s_waitcnt vmcnt(0)" ::: "memory");
        }
    }
    __syncthreads();
}
__device__ __forceinline__ int swap45(int p) { return (p & ~48) | ((p & 16) << 1) | ((p & 32) >> 1); }
template <int MODE>
__device__ __forceinline__ void transpose_item(const float* W, int ldw, int K, bf16* WT, int dbase, LAS float* scr_, int kb, int nb, int lane) {
    LAS unsigned char* scr = (LAS unsigned char*)scr_;
    const int k0 = 64 * kb, n0 = 64 * nb, kq = lane >> 4, nq = lane & 15;
    f32x4 v[16];
    const float* wp = W + (size_t)(k0 + 16 * kq) * ldw + n0 + 4 * nq;
#pragma unroll
    for (int j = 0; j < 16; ++j) v[j] = *(const f32x4*)(wp + (size_t)j * ldw);
#pragma unroll
    for (int c = 0; c < 4; ++c) { v4u lo, hi;
        lo.x = pk2(v[0][c], v[1][c]); lo.y = pk2(v[2][c], v[3][c]); lo.z = pk2(v[4][c], v[5][c]); lo.w = pk2(v[6][c], v[7][c]);
        hi.x = pk2(v[8][c], v[9][c]); hi.y = pk2(v[10][c], v[11][c]); hi.z = pk2(v[12][c], v[13][c]); hi.w = pk2(v[14][c], v[15][c]);
        const int n = 4 * nq + c, sw = nq & 7;
        *(LAS v4u*)(scr + n * 128 + 16 * ((2 * kq) ^ sw)) = lo; *(LAS v4u*)(scr + n * 128 + 16 * ((2 * kq + 1) ^ sw)) = hi; }
    asm volatile("s_waitcnt lgkmcnt(0)" ::: "memory");
    const int ch = lane & 7;
#pragma unroll
    for (int jj = 0; jj < 8; ++jj) { const int n = (lane >> 3) + 8 * jj;
        const v4u o = *(const LAS v4u*)(scr + n * 128 + 16 * (ch ^ ((n >> 2) & 7)));
        const int ns = n0 + n; int dr;
        if (MODE == 0) dr = ns; else dr = (ns < 1280) ? ((ns & ~63) | swap45(ns & 63)) : ns;
        *(v4u*)(WT + (size_t)(dbase + dr) * K + k0 + 8 * ch) = o; }
    asm volatile("s_waitcnt lgkmcnt(0)" ::: "memory");
}
template <int PART> __device__ __forceinline__ void phase0(const Args& a, LAS unsigned char* lds, int tid, int lane, int wave, int gw, int NGW) {
    unsigned char* ws = a.ws;
    LAS float* scr = (LAS float*)(lds + wave * 16384);
    {
        const float* c = a.in[I_C]; const float* W = a.in[I_WADA]; float* MODP = (float*)(ws + WS_MODP);
        constexpr int NB0 = 16, NBN = PART == 0 ? NB0 : 48 - NB0;
        if (PART == 0) {
            float* MODP0 = (float*)(ws + WS_MODP0);
            for (int wi = blockIdx.x; wi < 256; wi += gridDim.x) { const int kg = wi >> 6, cb = wi & 63, kb = 8 * kg + wave, r4 = lane >> 4, c4 = lane & 15;
                const float sv = siluf(c[64 * kb + lane]);
                f32x4 acc = {0.f, 0.f, 0.f, 0.f}, wv[16];
                const float* wp = W + (size_t)(64 * kb + r4) * 12288 + 64 * cb + 4 * c4;
#pragma unroll
                for (int i = 0; i < 16; ++i) wv[i] = *(const f32x4*)(wp + (size_t)(4 * i) * 12288);
#pragma unroll
                for (int i = 0; i < 16; ++i) acc += __shfl(sv, r4 + 4 * i) * wv[i];
#pragma unroll
                for (int q = 0; q < 4; ++q) { acc[q] += __shfl_xor(acc[q], 16); acc[q] += __shfl_xor(acc[q], 32); }
                if (lane < 16) *(LAS f32x4*)(scr + 4 * lane) = acc;
                __syncthreads();
                if (tid < 64) { float s = 0.f;
#pragma unroll
                    for (int w = 0; w < 8; ++w) s += *(const LAS float*)(lds + w * 16384 + 4 * tid);
                    MODP0[(size_t)(64 * cb + tid) * 4 + kg] = s; }
                __syncthreads(); }
        } else
        for (int it = gw; it < 32 * NBN; it += NGW) {
            const int kb = it / NBN, nb = it % NBN + (PART == 0 ? 0 : NB0);
            const float sv = siluf(c[64 * kb + lane]);
            f32x4 acc = {0.f, 0.f, 0.f, 0.f};
            const float* wp = W + (size_t)(64 * kb) * 12288 + 256 * nb + 4 * lane;
#pragma unroll 8
            for (int kk = 0; kk < 64; ++kk) { const float s = __shfl(sv, kk); const f32x4 w = *(const f32x4*)(wp + (size_t)kk * 12288); acc += s * w; }
            { float* mp = MODP + (size_t)(256 * nb + 4 * lane) * 32 + kb;
              mp[0] = acc.x; mp[32] = acc.y; mp[64] = acc.z; mp[96] = acc.w; }
        }
    }
    if (PART == 0) { const float* W = a.in[I_WIN]; float* PAN = (float*)(ws + WS_PAN);
        for (int idx = blockIdx.x * NTHR + tid; idx < 2048 * 8; idx += gridDim.x * NTHR) { const int k = idx >> 3, o = idx & 7; PAN[o * 2048 + k] = W[(size_t)k * INW + NIN + o]; } }
    if (PART == 0) {
        float* COS = (float*)(ws + WS_COS); float* SIN = (float*)(ws + WS_SIN);
        for (int idx = blockIdx.x * NTHR + tid; idx < T * 32; idx += gridDim.x * NTHR) {
            const int t = idx >> 5, i = idx & 31;
            const float angf = (float)t * ROPE_INV[i];
            const double x = (double)angf;
            const double q = __builtin_rint(x * 0.63661977236758134308);
            const double r = (x - q * 1.57079632679489655800) - q * 6.12323399573676603587e-17;
            const double r2 = r * r;
            const double sn = r * (1.0 + r2 * (-1.0 / 6 + r2 * (1.0 / 120 + r2 * (-1.0 / 5040 + r2 * (1.0 / 362880 + r2 * (-1.0 / 39916800 + r2 * (1.0 / 6227020800.0)))))));
            const double cs = 1.0 + r2 * (-0.5 + r2 * (1.0 / 24 + r2 * (-1.0 / 720 + r2 * (1.0 / 40320 + r2 * (-1.0 / 3628800 + r2 * (1.0 / 479001600 + r2 * (-1.0 / 87178291200.0)))))));
            const int qi = ((int)q) & 3;
            const double cv = (qi == 0) ? cs : (qi == 1) ? -sn : (qi == 2) ? -cs : sn;
            const double sv = (qi == 0) ? sn : (qi == 1) ? cs : (qi == 2) ? -sn : -cs;
            COS[idx] = (float)cv; SIN[idx] = (float)sv;
        }
    }
    if (PART == 1) { const float* wexp = a.in[I_WEXPERT]; const float* wgrp = a.in[I_WGROUP]; v4u* WCF = (v4u*)(ws + WS_WCH);
        for (int idx = gw * 64 + lane; idx < 80 * 256; idx += NGW * 64) { const int n = idx % 80, kk = idx / 80, k0 = kk * 8; float v[8];
#pragma unroll
            for (int j = 0; j < 8; ++j) v[j] = (n < 64) ? wexp[(size_t)(k0 + j) * 64 + n] : ((n < 72) ? wgrp[(size_t)(k0 + j) * 8 + (n - 64)] : 0.f);
            v4u hi, lo; unsigned* hp = (unsigned*)&hi; unsigned* lp = (unsigned*)&lo;
#pragma unroll
            for (int j = 0; j < 4; ++j) { const unsigned h = pk2(v[2 * j], v[2 * j + 1]); hp[j] = h; lp[j] = pk2(v[2 * j] - bf2f(h & 0xffffu), v[2 * j + 1] - bf2f(h >> 16)); }
            const int w_ = kk >> 5, blk = (kk >> 2) & 7, g = kk & 3, nt = n >> 4, i = n & 15; const size_t o = ((size_t)((w_ * 8 + blk) * 5 + nt) * 2) * 64 + 16 * g + i;
            WCF[o] = hi; WCF[o + 64] = lo; } }
    {
        bf16* WINT = (bf16*)(ws + WS_WINT); bf16* WOUTT = (bf16*)(ws + WS_WOUTT);
        constexpr int N_IN = 32 * 88, N_OUT = 32 * 32, N_IT = PART == 0 ? N_IN : N_OUT;
        const int nwg = NGW / NWAVES, bw = gw / NWAVES, per = (N_IT + nwg - 1) / nwg, lo = bw * per, hi = (lo + per < N_IT) ? lo + per : N_IT;
        for (int r = lo + wave; r < hi; r += NWAVES) {
            if (PART == 0) transpose_item<1>(a.in[I_WIN], INW, D, WINT, 0, scr, r / 88, r % 88, lane);
            else transpose_item<0>(a.in[I_WOUT], D, D, WOUTT, 0, scr, r / 32, r % 32, lane);
        }
    }
}

__device__ __forceinline__ float mod_sum(const float* MODP, const float* b_ada, int n) {
    const f32x4* p = (const f32x4*)(MODP + (size_t)n * 32); f32x4 v[8];
#pragma unroll
    for (int q = 0; q < 8; ++q) v[q] = p[q];
    float s = b_ada[n];
#pragma unroll
    for (int q = 0; q < 8; ++q) { s += v[q].x; s += v[q].y; s += v[q].z; s += v[q].w; }
    return s; }

__device__ __forceinline__ void phase1(const Args& a, LAS unsigned char* lds, int tid, int lane, int wave) {
    unsigned char* ws = a.ws;
    const float* PAN = (const float*)(ws + WS_PAN);
    LAS float* lmod = (LAS float*)lds;
    LAS float* panel = (LAS float*)(lds + 16384);
    const float* x = a.in[I_X]; const float* g = a.in[I_GPREMIX]; bf16* HN = (bf16*)(ws + WS_HN); float* GATES = (float*)(ws + WS_GATES); const float* bg = a.in[I_BGATES];
    const int gw = blockIdx.x * NWAVES + wave, NGW = gridDim.x * NWAVES;
    f32x4 va[8], vb[8], gvv[8];
#pragma unroll
    for (int j = 0; j < 8; ++j) gvv[j] = *(const f32x4*)(g + 4 * lane + 256 * j);
#define P1_LOAD(v_, t_) do { const f32x4* xr_ = (const f32x4*)(x + (size_t)(t_) * D) + lane; _Pragma("unroll") for (int j_ = 0; j_ < 8; ++j_) v_[j_] = xr_[64 * j_]; } while (0)
    int t = gw;
    if (t < T) P1_LOAD(va, t);
    {
        const float* bada = a.in[I_BADA]; const f32x4* MODP0 = (const f32x4*)(ws + WS_MODP0); f32x4 pv_[8];
#pragma unroll
        for (int q = 0; q < 8; ++q) pv_[q] = MODP0[tid + q * NTHR];
#pragma unroll
        for (int q = 0; q < 8; ++q) { const int n = tid + q * NTHR; lmod[n] = bada[n] + ((pv_[q].x + pv_[q].y) + (pv_[q].z + pv_[q].w)); }
    }
    for (int idx = tid; idx < 2048 * 8 / 4; idx += NTHR) *(LAS f32x4*)(panel + 4 * idx) = *(const f32x4*)(PAN + 4 * idx);
    __syncthreads();
#define P1_ROW(v_, t_) do { float ss_ = 0.f; \
        _Pragma("unroll") for (int j_ = 0; j_ < 8; ++j_) ss_ += (v_[j_].x * v_[j_].x + v_[j_].y * v_[j_].y) + (v_[j_].z * v_[j_].z + v_[j_].w * v_[j_].w); \
        ss_ = wave_sum(ss_); const float rstd_ = 1.0f / sqrtf(ss_ * (1.0f / D) + EPS); \
        float gp_[8] = {0.f, 0.f, 0.f, 0.f, 0.f, 0.f, 0.f, 0.f}; \
        _Pragma("unroll") for (int j_ = 0; j_ < 8; ++j_) { const int k_ = 4 * lane + 256 * j_; \
            const f32x4 gv_ = gvv[j_], sh_ = *(const LAS f32x4*)(lmod + k_), sc_ = *(const LAS f32x4*)(lmod + 2048 + k_); \
            f32x4 h_ = (v_[j_] * rstd_) * gv_; h_ = h_ * (sc_ + 1.0f) + sh_; \
            *(v2u*)(HN + (size_t)(t_) * D + k_) = pk4(h_); \
            _Pragma("unroll") for (int o_ = 0; o_ < 8; ++o_) { const f32x4 w_ = *(const LAS f32x4*)(panel + o_ * 2048 + k_); gp_[o_] += (h_.x * w_.x + h_.y * w_.y) + (h_.z * w_.z + h_.w * w_.w); } \
            __builtin_amdgcn_sched_barrier(0); } \
        _Pragma("unroll") for (int o_ = 0; o_ < 8; ++o_) gp_[o_] = wave_sum(gp_[o_]); \
        if (lane == 0) { _Pragma("unroll") for (int o_ = 0; o_ < 8; ++o_) GATES[(size_t)(t_) * 8 + o_] = gp_[o_] + bg[o_]; } } while (0)
    for (; t < T; t += 2 * NGW) {
        const int t2 = t + NGW, t3 = t + 2 * NGW;
        if (t2 < T) P1_LOAD(vb, t2);
        P1_ROW(va, t);
        if (t2 < T) { if (t3 < T) P1_LOAD(va, t3); P1_ROW(vb, t2); }
    }
#undef P1_LOAD
#undef P1_ROW
}

struct EpiIn {
    static constexpr bool PERM = false, AFTER_DRAIN = false;
    bf16 *Qa, *Ka, *Va, *MQ0, *MK0, *MV, *MO; const float *COS, *SIN;
    __device__ __forceinline__ void operator()(const pg8::f32x4 (&acc)[2][2][4][2], const pg8::Unit& u, int wr, int wc, int fr, int fq) const {
        const int pn = u.pn;
        if (pn < 5) {
            const int L0 = 16 * (wc & 1) + 4 * fq;
#pragma unroll
            for (int ai = 0; ai < 2; ++ai)
#pragma unroll
                for (int m = 0; m < 4; ++m) {
                    const int row = u.pm * 256 + ai * 128 + wr * 64 + m * 16 + fr;
                    const f32x4 c = *(const f32x4*)(COS + (size_t)row * 32 + L0), s = *(const f32x4*)(SIN + (size_t)row * 32 + L0);
#pragma unroll
                    for (int bj = 0; bj < 2; ++bj) {
                        const int hh = 2 * bj + (wc >> 1);
                        const f32x4 t1 = acc[ai][bj][m][0], t2 = acc[ai][bj][m][1];
                        f32x4 o1 = t1 * c - t2 * s, o2 = t2 * c + t1 * s;
                        bf16* dst;
                        if (pn < 4) { o1 = o1 * 0.125f; o2 = o2 * 0.125f; dst = Qa + (size_t)row * NQW + (pn * 4 + hh) * 64; }
                        else dst = Ka + (size_t)row * NKVW + hh * 64;
                        *(v2u*)(dst + L0) = pk4(o1); *(v2u*)(dst + 32 + L0) = pk4(o2);
                    }
                }
        } else {
            bf16* base; int ld, cb;
            if (pn == 5) { base = Va; ld = NKVW; cb = 0; }
            else if (pn < 10) { base = MQ0; ld = MW; cb = (pn - 6) * 256; }
            else if (pn < 14) { base = MK0; ld = MW; cb = (pn - 10) * 256; }
            else if (pn < 18) { base = MV; ld = MW; cb = (pn - 14) * 256; }
            else { base = MO; ld = MW; cb = (pn - 18) * 256; }
#pragma unroll
            for (int ai = 0; ai < 2; ++ai)
#pragma unroll
                for (int m = 0; m < 4; ++m) {
                    const int row = u.pm * 256 + ai * 128 + wr * 64 + m * 16 + fr;
                    bf16* rp = base + (size_t)row * ld + cb + 32 * wc + 4 * fq;
#pragma unroll
                    for (int bj = 0; bj < 2; ++bj)
#pragma unroll
                        for (int n = 0; n < 2; ++n) *(v2u*)(rp + 128 * bj + 16 * n) = pk4(acc[ai][bj][m][n]);
                }
        }
    }
};

__device__ __forceinline__ void attn_item(const Args& a, LAS unsigned char* lds, int qb, int kvh, int tid, int lane, int wave) {
    unsigned char* ws = a.ws;
    const bf16* Qa = (const bf16*)(ws + WS_QA); const bf16* Ka = (const bf16*)(ws + WS_KA); const bf16* Va = (const bf16*)(ws + WS_VA); bf16* YMIX = (bf16*)(ws + WS_YMIX);
    LAS unsigned char* Kimg = lds; LAS unsigned char* Vimg = lds + 192 * 144;
    const int q0 = qb * 64, kbase = q0 - 128;
    for (int idx = tid; idx < 192 * 8; idx += NTHR) { const int r = idx >> 3, ch = idx & 7, t = kbase + r; v4u kv = {0u, 0u, 0u, 0u}, vv = {0u, 0u, 0u, 0u};
        if (t >= 0) { kv = *(const v4u*)(Ka + (size_t)t * NKVW + kvh * 64 + ch * 8); vv = *(const v4u*)(Va + (size_t)t * NKVW + kvh * 64 + ch * 8); }
        *(LAS v4u*)(Kimg + r * 144 + ch * 16) = kv; *(LAS v4u*)(Vimg + r * 144 + ch * 16) = vv; }
    __syncthreads();
    const int g = lane >> 4, i = lane & 15, q4 = (lane >> 2) & 3, p4 = lane & 3;
    const int head = kvh * 4 + (wave >> 1), qw0 = q0 + 32 * (wave & 1);
    bf16x8 qf[2][2];
#pragma unroll
    for (int qt = 0; qt < 2; ++qt)
#pragma unroll
        for (int ks = 0; ks < 2; ++ks) qf[qt][ks] = *(const bf16x8*)(Qa + (size_t)(qw0 + 16 * qt + i) * NQW + head * 64 + 32 * ks + 8 * g);
    f32x4 sacc[12][2];
#pragma unroll
    for (int kt = 0; kt < 12; ++kt) { sacc[kt][0] = (f32x4){0.f, 0.f, 0.f, 0.f}; sacc[kt][1] = (f32x4){0.f, 0.f, 0.f, 0.f}; }
#pragma unroll
    for (int kt = 0; kt < 12; ++kt)
#pragma unroll
        for (int ks = 0; ks < 2; ++ks) { const bf16x8 kf = *(const LAS bf16x8*)(Kimg + (16 * kt + i) * 144 + (32 * ks + 8 * g) * 2);
            sacc[kt][0] = MFMA16(kf, qf[0][ks], sacc[kt][0]); sacc[kt][1] = MFMA16(kf, qf[1][ks], sacc[kt][1]); }
    const float sink = a.in[I_SINKS][head];
    float linv[2];
#pragma unroll
    for (int qt = 0; qt < 2; ++qt) {
        const int qp = qw0 + 16 * qt + i;
        float mx = sink;
#pragma unroll
        for (int kt = 0; kt < 12; ++kt)
#pragma unroll
            for (int r = 0; r < 4; ++r) { const int kp = kbase + 16 * kt + 4 * g + r; const bool valid = (kp >= 0) && (kp <= qp) && (qp - kp < 128);
                const float s = valid ? sacc[kt][qt][r] : -INFINITY; sacc[kt][qt][r] = s; mx = fmaxf(mx, s); }
        mx = fmaxf(mx, __shfl_xor(mx, 16)); mx = fmaxf(mx, __shfl_xor(mx, 32));
        float l = 0.f;
#pragma unroll
        for (int kt = 0; kt < 12; ++kt)
#pragma unroll
            for (int r = 0; r < 4; ++r) { const float p = __expf(sacc[kt][qt][r] - mx); sacc[kt][qt][r] = p; l += p; }
        l += __shfl_xor(l, 16); l += __shfl_xor(l, 32);
        l += __expf(sink - mx);
        linv[qt] = 1.0f / l;
    }
    f32x4 oacc[4][2];
#pragma unroll
    for (int dt = 0; dt < 4; ++dt) { oacc[dt][0] = (f32x4){0.f, 0.f, 0.f, 0.f}; oacc[dt][1] = (f32x4){0.f, 0.f, 0.f, 0.f}; }
#pragma unroll
    for (int u = 0; u < 6; ++u) {
        const bf16x8 pf0 = pack8(sacc[2 * u][0], sacc[2 * u + 1][0]), pf1 = pack8(sacc[2 * u][1], sacc[2 * u + 1][1]);
#pragma unroll
        for (int dt = 0; dt < 4; ++dt) {
            const s16x4 a1 = tr16(Vimg + (32 * u + 4 * g + q4) * 144 + (16 * dt + 4 * p4) * 2);
            const s16x4 a2 = tr16(Vimg + (32 * u + 16 + 4 * g + q4) * 144 + (16 * dt + 4 * p4) * 2);
            const bf16x8 vf = cat8(a1, a2);
            oacc[dt][0] = MFMA16(vf, pf0, oacc[dt][0]); oacc[dt][1] = MFMA16(vf, pf1, oacc[dt][1]);
        }
    }
#pragma unroll
    for (int qt = 0; qt < 2; ++qt)
#pragma unroll
        for (int dt = 0; dt < 4; ++dt) { const f32x4 o = oacc[dt][qt] * linv[qt];
            *(v2u*)(YMIX + (size_t)(qw0 + 16 * qt + i) * D + head * 64 + 16 * dt + 4 * g) = pk4(o); }
    __syncthreads();
}

__device__ __forceinline__ void conv_phase(const Args& a, int tid) {
    unsigned char* ws = a.ws;
    { const float* MODP = (const float*)(ws + WS_MODP); float* MODF = (float*)(ws + WS_MODF);
      for (int n = 4096 + blockIdx.x * NTHR + tid; n < 12288; n += gridDim.x * NTHR) MODF[n] = mod_sum(MODP, a.in[I_BADA], n);
      float* ABC = (float*)(ws + WS_ABC); const float* gpm = a.in[I_GPOSTMIX]; const float* gpf = a.in[I_GPREFFN];
      for (int n = blockIdx.x * NTHR + tid; n < 2048; n += gridDim.x * NTHR) { const float g1 = mod_sum(MODP, a.in[I_BADA], 2 * 2048 + n), s2 = mod_sum(MODP, a.in[I_BADA], 3 * 2048 + n), c2 = mod_sum(MODP, a.in[I_BADA], 4 * 2048 + n);
          ABC[n] = g1 * gpm[n]; ABC[2048 + n] = gpf[n] * (c2 + 1.0f); ABC[4096 + n] = s2; } }
    const bf16* MQ0 = (const bf16*)(ws + WS_MQ0); const bf16* MK0 = (const bf16*)(ws + WS_MK0); bf16* MQ = (bf16*)(ws + WS_MQ); bf16* MK = (bf16*)(ws + WS_MK);
    const float* cw = a.in[I_CONVW]; const float* cb = a.in[I_CONVB];
    for (int idx = blockIdx.x * NTHR + tid; idx < (T / 16) * 256; idx += gridDim.x * NTHR) {
        const int cc = (idx & 255) * 8, t0 = (idx >> 8) * 16;
        const bf16* src; bf16* dst; float scale; int c0;
        if (cc < 1024) { src = MQ0; dst = MQ; c0 = cc; scale = 1.0f; } else { src = MK0; dst = MK; c0 = cc - 1024; scale = 0.0625f; }
        v4u xs[19];
#pragma unroll
        for (int r = 0; r < 19; ++r) { const int tt = t0 - 3 + r; xs[r] = (v4u){0u, 0u, 0u, 0u}; if (tt >= 0) xs[r] = *(const v4u*)(src + (size_t)tt * MW + c0); }
        float w[4][8], bb[8];
#pragma unroll
        for (int j = 0; j < 4; ++j) { const f32x4 w0 = *(const f32x4*)(cw + j * 2048 + cc), w1 = *(const f32x4*)(cw + j * 2048 + cc + 4);
            w[j][0] = w0.x; w[j][1] = w0.y; w[j][2] = w0.z; w[j][3] = w0.w; w[j][4] = w1.x; w[j][5] = w1.y; w[j][6] = w1.z; w[j][7] = w1.w; }
        { const f32x4 b0 = *(const f32x4*)(cb + cc), b1 = *(const f32x4*)(cb + cc + 4); bb[0] = b0.x; bb[1] = b0.y; bb[2] = b0.z; bb[3] = b0.w; bb[4] = b1.x; bb[5] = b1.y; bb[6] = b1.z; bb[7] = b1.w; }
#pragma unroll
        for (int r = 0; r < 16; ++r) {
            float y[8];
#pragma unroll
            for (int e = 0; e < 8; ++e) y[e] = bb[e];
#pragma unroll
            for (int j = 0; j < 4; ++j) { const v4u xv = xs[r + j];
                y[0] += bf2f(xv.x & 0xffffu) * w[j][0]; y[1] += bf2f(xv.x >> 16) * w[j][1]; y[2] += bf2f(xv.y & 0xffffu) * w[j][2]; y[3] += bf2f(xv.y >> 16) * w[j][3];
                y[4] += bf2f(xv.z & 0xffffu) * w[j][4]; y[5] += bf2f(xv.z >> 16) * w[j][5]; y[6] += bf2f(xv.w & 0xffffu) * w[j][6]; y[7] += bf2f(xv.w >> 16) * w[j][7]; }
            v4u o; o.x = pk2(siluf(y[0]) * scale, siluf(y[1]) * scale); o.y = pk2(siluf(y[2]) * scale, siluf(y[3]) * scale); o.z = pk2(siluf(y[4]) * scale, siluf(y[5]) * scale); o.w = pk2(siluf(y[6]) * scale, siluf(y[7]) * scale);
            *(v4u*)(dst + (size_t)(t0 + r) * MW + c0) = o;
        }
    }
}

__device__ __forceinline__ void gate_prep(const Args& a, LAS unsigned char* lds, int hh, int tid, int lane, int wave) {
    unsigned char* ws = a.ws;
    const float* GATES = (const float*)(ws + WS_GATES);
    float* GA = (float*)(ws + WS_GA) + (size_t)hh * T; float* GB = (float*)(ws + WS_GB) + (size_t)hh * T; float* GM = (float*)(ws + WS_GM) + (size_t)hh * T;
    float* CSG = (float*)(ws + WS_CS) + hh * 128; float* CSM = (float*)(ws + WS_CS) + 512 + hh * 128;
    LAS float* Lb = (LAS float*)lds;
    LAS float* Lm = Lb + 128;
    LAS float* Ls = Lb + 256;
    float bb[16], be[16], pm[16];
#pragma unroll
    for (int cc = 0; cc < 16; ++cc) {
        const int c = wave + 8 * cc, t = c * 64 + lane;
        const float ig = GATES[(size_t)t * 8 + hh], fg = GATES[(size_t)t * 8 + 4 + hh];
        const float logf = fminf(fg, 0.f) - log1pf(__expf(-fabsf(fg)));
        float b = logf;
#pragma unroll
        for (int o = 1; o < 64; o <<= 1) { const float u = __shfl_up(b, o); if (lane >= o) b += u; }
        const float blast = __shfl(b, 63);
        const float beta = ig - b;
        float p = beta;
#pragma unroll
        for (int o = 1; o < 64; o <<= 1) { const float u = __shfl_up(p, o); if (lane >= o) p = fmaxf(p, u); }
        const float mloc = blast + __shfl(p, 63);
        if (lane == 0) { Lb[c] = blast; Lm[c] = mloc; }
        bb[cc] = b; be[cc] = beta; pm[cc] = p;
    }
    __syncthreads();
    if (tid == 0) { float m = 0.f; Ls[0] = 0.f; for (int c = 0; c < 128; ++c) { m = fmaxf(Lb[c] + m, Lm[c]); Ls[c + 1] = m; } }
    __syncthreads();
#pragma unroll
    for (int cc = 0; cc < 16; ++cc) {
        const int c = wave + 8 * cc, t = c * 64 + lane;
        const float m = Ls[c];
        const float mx = fmaxf(m, pm[cc]);
        GA[t] = -mx; GB[t] = be[cc]; GM[t] = bb[cc] + mx;
        if (lane == 0) { CSG[c] = Lb[c] - Ls[c + 1]; CSM[c] = m; }
    }
    __syncthreads();
}
constexpr int MC_Q = 0, MC_K = 33792, MC_V = 67584, MC_VW = 84992, MC_SW = 102400, MC_SC = 111616;
constexpr int NSEG = 21;
__device__ __forceinline__ int seg_begin(int g) { return g < 7 ? 7 * g : (g < 16 ? 49 + 6 * (g - 7) : 103 + 5 * (g - 16)); }
static_assert(103 + 5 * (21 - 16) == 128, "segments cover the 128 chunks");
constexpr size_t WS_LB = WS_Y;
template <bool SO, bool den_item>
__device__ __forceinline__ void mlstm_item(const Args& a, LAS unsigned char* lds, int hh, int eh, int seg, int tid, int lane, int wave) {
    unsigned char* ws = a.ws;
    const bf16* MQ = (const bf16*)(ws + WS_MQ); const bf16* MK = (const bf16*)(ws + WS_MK); const bf16* MV = (const bf16*)(ws + WS_MV);
    const float* GA = (const float*)(ws + WS_GA) + (size_t)hh * T; const float* GB = (const float*)(ws + WS_GB) + (size_t)hh * T;
    const float* CSG = (const float*)(ws + WS_CS) + hh * 128; const float* CSM = (const float*)(ws + WS_CS) + 512 + hh * 128;
    float* NUM = (float*)(ws + WS_NUM); float* DEN = (float*)(ws + WS_DEN) + (size_t)hh * T; float* LB = (float*)(ws + WS_LB);
    const int g = lane >> 4, i = lane & 15, q4 = (lane >> 2) & 3, p4 = lane & 3, et = wave;
    LAS unsigned char* Qi = lds + MC_Q; LAS unsigned char* Ki = lds + MC_K; LAS unsigned char* Vi = lds + MC_V; LAS unsigned char* Vw = lds + MC_VW; LAS unsigned char* Sw = lds + MC_SW;
    LAS float* SC = (LAS float*)(lds + MC_SC);
    const int c0 = seg_begin(seg), c1 = seg_begin(seg + 1);
    const unsigned vonum = (unsigned)((4 * g * MW + i) * 4);
    f32x4 Dst[16];
#pragma unroll
    for (int dt = 0; dt < 16; ++dt) Dst[dt] = (f32x4){0.f, 0.f, 0.f, 0.f};
    if (!SO) {
        const f32x4* Lp0 = (const f32x4*)(LB + ((((size_t)(hh * 3 + eh) * NSEG) * 8 + wave) * 16) * 256) + lane;
        f32x4 Lc[8], Ln[8];
        if (seg > 0) {
#pragma unroll
            for (int dt = 0; dt < 8; ++dt) Lc[dt] = Lp0[dt * 64];
        }
#pragma unroll 1
        for (int gp = 0; gp < seg; ++gp) {
            float la = 0.f;
            for (int c = seg_begin(gp); c < seg_begin(gp + 1); ++c) la += CSG[c] + CSM[c];
            const float A = __expf(la);
            const f32x4* Lg = Lp0 + (size_t)gp * (8 * 16 * 64);
#pragma unroll
            for (int dt = 0; dt < 8; ++dt) Ln[dt] = Lg[(8 + dt) * 64];
#pragma unroll
            for (int dt = 0; dt < 8; ++dt) Dst[dt] = Dst[dt] * A + Lc[dt];
            const f32x4* Lgn = Lp0 + (size_t)((gp + 1 < seg) ? gp + 1 : gp) * (8 * 16 * 64);
#pragma unroll
            for (int dt = 0; dt < 8; ++dt) Lc[dt] = Lgn[dt * 64];
#pragma unroll
            for (int dt = 0; dt < 8; ++dt) Dst[8 + dt] = Dst[8 + dt] * A + Ln[dt];
        }
    }
    v4u pq[4], pk[4], pv[2]; float pgb[2], pal = 0.f, pbe = 0.f;
    const char* MQu = (const char*)(MQ + hh * 256); const char* MKu = (const char*)(MK + hh * 256); const char* MVu = (const char*)(MV + hh * 256 + (den_item ? 0 : eh * 128));
    const unsigned voqk = (unsigned)(((tid >> 5) * MW + (tid & 31) * 8) * 2), vov = (unsigned)(((tid >> 4) * MW + (tid & 15) * 8) * 2), vogb = (unsigned)((tid >> 4) * 4);
#define MC_ISSUE(c_) do { const size_t tb_ = (size_t)(c_) * 64 * MW * 2; \
        _Pragma("unroll") for (int j_ = 0; j_ < 4; ++j_) pk[j_] = *(const v4u*)(MKu + (tb_ + (size_t)j_ * 16 * MW * 2) + voqk); \
        _Pragma("unroll") for (int j_ = 0; j_ < 2; ++j_) { pgb[j_] = *(const float*)((const char*)(GB + (c_) * 64 + j_ * 32) + vogb); \
            if (!den_item) pv[j_] = *(const v4u*)(MVu + (tb_ + (size_t)j_ * 32 * MW * 2) + vov); } \
        if (!SO && tid < 64) { pal = GA[(c_) * 64 + tid]; pbe = GB[(c_) * 64 + tid]; } } while (0)
#define MC_ISSUE_Q(c_) do { const size_t tb_ = (size_t)(c_) * 64 * MW * 2; \
        _Pragma("unroll") for (int j_ = 0; j_ < 4; ++j_) pq[j_] = *(const v4u*)(MQu + (tb_ + (size_t)j_ * 16 * MW * 2) + voqk); } while (0)
#define MC_STORE(c_) do { const float gam_ = CSG[(c_)], mp_ = CSM[(c_)]; \
        _Pragma("unroll") for (int j_ = 0; j_ < 4; ++j_) { const int idx_ = tid + j_ * NTHR, r_ = idx_ >> 5, ch_ = idx_ & 31; \
            if (!SO) *(LAS v4u*)(Qi + r_ * 528 + ch_ * 16) = pq[j_]; *(LAS v4u*)(Ki + r_ * 528 + ch_ * 16) = pk[j_]; } \
        _Pragma("unroll") for (int j_ = 0; j_ < 2; ++j_) { const int idx_ = tid + j_ * NTHR, r_ = idx_ >> 4, ch_ = idx_ & 15; \
            const float w_ = __expf(pgb[j_] + gam_); v4u vv_, vw_; \
            if (!den_item) { vv_ = pv[j_]; \
                vw_.x = pk2(bf2f(vv_.x & 0xffffu) * w_, bf2f(vv_.x >> 16) * w_); vw_.y = pk2(bf2f(vv_.y & 0xffffu) * w_, bf2f(vv_.y >> 16) * w_); \
                vw_.z = pk2(bf2f(vv_.z & 0xffffu) * w_, bf2f(vv_.z >> 16) * w_); vw_.w = pk2(bf2f(vv_.w & 0xffffu) * w_, bf2f(vv_.w >> 16) * w_); \
            } else { vv_ = (v4u){0u, 0u, 0u, 0u}; vw_ = (v4u){0u, 0u, 0u, 0u}; if (ch_ == 0) { vv_.x = 0x3f80u; vw_.x = pk2(w_, 0.f); } } \
            if (!SO) *(LAS v4u*)(Vi + r_ * 272 + ch_ * 16) = vv_; *(LAS v4u*)(Vw + r_ * 272 + ch_ * 16) = vw_; } \
        if (!SO && tid < 64) { SC[tid] = pal; SC[64 + tid] = pbe; SC[192 + tid] = __expf(pal + mp_); } } while (0)
    MC_ISSUE(c0); if (!SO) MC_ISSUE_Q(c0);
    MC_STORE(c0);
    __syncthreads();
    for (int c = c0; c < c1; ++c) {
        const int t0 = c * 64;
        const float a_old = __expf(CSG[c] + CSM[c]);
        if (c + 1 < c1) MC_ISSUE(c + 1);
        if (!SO) {
            f32x4 iacc[4];
            const int lt = wave >> 1;
#pragma unroll
            for (int sti = 0; sti < 2; ++sti) {
                const int st = 2 * (wave & 1) + sti;
                f32x4 acc = {0.f, 0.f, 0.f, 0.f};
#pragma unroll
                for (int ks = 0; ks < 8; ++ks) { const bf16x8 af = *(const LAS bf16x8*)(Qi + (16 * lt + i) * 528 + (32 * ks + 8 * g) * 2);
                    const bf16x8 bf = *(const LAS bf16x8*)(Ki + (16 * st + i) * 528 + (32 * ks + 8 * g) * 2); acc = MFMA16(af, bf, acc); }
                const int s = 16 * st + i; const float bs = SC[64 + s];
#pragma unroll
                for (int r = 0; r < 4; ++r) { const int l = 16 * lt + 4 * g + r; const float val = (s <= l) ? acc[r] * __expf(SC[l] + bs) : 0.f;
                    *(LAS unsigned short*)(Sw + l * 144 + s * 2) = (unsigned short)(pk2(val, 0.f) & 0xffffu); }
            }
#pragma unroll
            for (int lt2 = 0; lt2 < 4; ++lt2) iacc[lt2] = (f32x4){0.f, 0.f, 0.f, 0.f};
#pragma unroll
            for (int kb = 0; kb < 8; ++kb) {
                const bf16x8 bfr = pack8(Dst[2 * kb], Dst[2 * kb + 1]);
#pragma unroll
                for (int lt2 = 0; lt2 < 4; ++lt2) {
                    const v2u lo = *(const LAS v2u*)(Qi + (16 * lt2 + i) * 528 + (32 * kb + 4 * g) * 2), hi = *(const LAS v2u*)(Qi + (16 * lt2 + i) * 528 + (32 * kb + 16 + 4 * g) * 2);
                    v4u av; av.x = lo.x; av.y = lo.y; av.z = hi.x; av.w = hi.y;
                    iacc[lt2] = MFMA16(__builtin_bit_cast(bf16x8, av), bfr, iacc[lt2]);
                }
            }
#pragma unroll
            for (int lt2 = 0; lt2 < 4; ++lt2)
#pragma unroll
                for (int r = 0; r < 4; ++r) iacc[lt2][r] *= SC[192 + 16 * lt2 + 4 * g + r];
            __syncthreads();
#pragma unroll
            for (int ks2 = 0; ks2 < 2; ++ks2) {
                const bf16x8 bfr = cat8(tr16(Vi + (32 * ks2 + 8 * g + q4) * 272 + (16 * et + 4 * p4) * 2), tr16(Vi + (32 * ks2 + 8 * g + 4 + q4) * 272 + (16 * et + 4 * p4) * 2));
#pragma unroll
                for (int lt2 = 0; lt2 < 4; ++lt2) { const bf16x8 afr = *(const LAS bf16x8*)(Sw + (16 * lt2 + i) * 144 + (32 * ks2 + 8 * g) * 2); iacc[lt2] = MFMA16(afr, bfr, iacc[lt2]); }
            }
#pragma unroll
            for (int lt2 = 0; lt2 < 4; ++lt2)
#pragma unroll
                for (int r = 0; r < 4; ++r) { const float o = iacc[lt2][r];
                    if (!den_item) *(float*)((char*)(NUM + (size_t)(t0 + 16 * lt2 + r) * MW + hh * 256 + eh * 128 + 16 * et) + vonum) = o;
                    else if (wave == 0 && i == 0) DEN[t0 + 16 * lt2 + 4 * g + r] = o; }
        }
#pragma unroll
        for (int dt = 0; dt < 16; ++dt) Dst[dt] = Dst[dt] * a_old;
#pragma unroll
        for (int ks2 = 0; ks2 < 2; ++ks2) {
            const bf16x8 bfr = cat8(tr16(Vw + (32 * ks2 + 8 * g + q4) * 272 + (16 * et + 4 * p4) * 2), tr16(Vw + (32 * ks2 + 8 * g + 4 + q4) * 272 + (16 * et + 4 * p4) * 2));
#pragma unroll
            for (int dt = 0; dt < 16; ++dt) {
                const bf16x8 afr = cat8(tr16(Ki + (32 * ks2 + 8 * g + q4) * 528 + (16 * dt + 4 * p4) * 2), tr16(Ki + (32 * ks2 + 8 * g + 4 + q4) * 528 + (16 * dt + 4 * p4) * 2));
                Dst[dt] = MFMA16(afr, bfr, Dst[dt]);
            }
        }
        if (!SO && c + 1 < c1) MC_ISSUE_Q(c + 1);
        __syncthreads();
        if (c + 1 < c1) { MC_STORE(c + 1); }
        __syncthreads();
    }
#undef MC_ISSUE
#undef MC_ISSUE_Q
#undef MC_STORE
    if (SO) {
        f32x4* Lp = (f32x4*)(LB + ((((size_t)(hh * 3 + eh) * NSEG + seg) * 8 + wave) * 16) * 256) + lane;
#pragma unroll
        for (int dt = 0; dt < 16; ++dt) Lp[dt * 64] = Dst[dt];
    }
}

__device__ __forceinline__ void mlstm_norm_phase(const Args& a, int lane, int wave) {
    unsigned char* ws = a.ws;
    const float* NUM = (const float*)(ws + WS_NUM); const float* DEN = (const float*)(ws + WS_DEN); const float* GM = (const float*)(ws + WS_GM);
    const bf16* MO = (const bf16*)(ws + WS_MO); bf16* YMIX = (bf16*)(ws + WS_YMIX); const float* mn = a.in[I_MNORM];
    const int gw = blockIdx.x * NWAVES + wave, NGW = gridDim.x * NWAVES;
    f32x4 nva, nvb; float dena, denb, mta, mtb; v2u moa, mob;
#define P5_LOAD(nv_, den_, mt_, mo_, it_) do { const int t_ = (it_) >> 2, hh_ = (it_) & 3; nv_ = *(const f32x4*)(NUM + (size_t)t_ * MW + hh_ * 256 + 4 * lane); \
        den_ = DEN[(size_t)hh_ * T + t_]; mt_ = GM[(size_t)hh_ * T + t_]; mo_ = *(const v2u*)(MO + (size_t)t_ * MW + hh_ * 256 + 4 * lane); } while (0)
#define P5_ITEM(nv_, den_, mt_, mo_, it_) do { const int t_ = (it_) >> 2, hh_ = (it_) & 3; \
        const float dd_ = fmaxf(fabsf(den_), __expf(-mt_)); const f32x4 h_ = nv_ / dd_; \
        const float ss_ = wave_sum((h_.x * h_.x + h_.y * h_.y) + (h_.z * h_.z + h_.w * h_.w)); const float r_ = 1.0f / sqrtf(ss_ * (1.0f / 256.0f) + EPS); \
        const f32x4 mv_ = *(const f32x4*)(mn + hh_ * 256 + 4 * lane); f32x4 y_; \
        y_.x = sigmoidf_(bf2f(mo_.x & 0xffffu)) * (h_.x * r_ * mv_.x); y_.y = sigmoidf_(bf2f(mo_.x >> 16)) * (h_.y * r_ * mv_.y); \
        y_.z = sigmoidf_(bf2f(mo_.y & 0xffffu)) * (h_.z * r_ * mv_.z); y_.w = sigmoidf_(bf2f(mo_.y >> 16)) * (h_.w * r_ * mv_.w); \
        *(v2u*)(YMIX + (size_t)t_ * D + 1024 + hh_ * 256 + 4 * lane) = pk4(y_); } while (0)
    int it = gw; const int NIT = T * 4;
    if (it < NIT) P5_LOAD(nva, dena, mta, moa, it);
    for (; it < NIT; it += 2 * NGW) {
        const int i2 = it + NGW, i3 = it + 2 * NGW;
        if (i2 < NIT) P5_LOAD(nvb, denb, mtb, mob, i2);
        P5_ITEM(nva, dena, mta, moa, it);
        if (i2 < NIT) { if (i3 < NIT) P5_LOAD(nva, dena, mta, moa, i3); P5_ITEM(nvb, denb, mtb, mob, i2); }
    }
#undef P5_LOAD
#undef P5_ITEM
}

struct EpiY {
    static constexpr bool PERM = false, AFTER_DRAIN = false;
    float* Y;
    __device__ __forceinline__ void operator()(const pg8::f32x4 (&acc)[2][2][4][2], const pg8::Unit& u, int wr, int wc, int fr, int fq) const {
#pragma unroll
        for (int ai = 0; ai < 2; ++ai)
#pragma unroll
            for (int m = 0; m < 4; ++m) {
                const int row = u.pm * 256 + ai * 128 + wr * 64 + m * 16 + fr;
                float* rp = Y + (size_t)row * D + u.pn * 256 + 32 * wc + 4 * fq;
#pragma unroll
                for (int bj = 0; bj < 2; ++bj)
#pragma unroll
                    for (int n = 0; n < 2; ++n) *(f32x4*)(rp + 128 * bj + 16 * n) = acc[ai][bj][m][n];
            }
    }
};

__device__ __forceinline__ void phase7(const Args& a, LAS unsigned char* lds, int tid, int lane, int wave) {
    unsigned char* ws = a.ws;
    const float* MODF = (const float*)(ws + WS_MODF); const float* Y = (const float*)(ws + WS_Y); float* X1 = (float*)(ws + WS_X1); bf16* HN = (bf16*)(ws + WS_HN);
    float* RW = (float*)(ws + WS_ROUTE + 65536);
    LAS int* rex = (LAS int*)(lds + 137216);
    int npass = 0;
    const float* x = a.in[I_X]; const float* bexp = a.in[I_BEXPERT]; const float* bgrp = a.in[I_BGROUP];
    constexpr int HP = 2052;
    LAS float* H2 = (LAS float*)lds;
    LAS float* LG = (LAS float*)(lds + 131584);
    const float* ABC = (const float*)(ws + WS_ABC);
    const __amdgpu_buffer_rsrc_t rW = __builtin_amdgcn_make_buffer_rsrc((void*)(ws + WS_WCH), (short)0, 80 * 2048 * 4, 0x00020000);
    for (int base = blockIdx.x * 16; base < T; base += gridDim.x * 16) {
        {
            const int r0 = 2 * wave, t0 = base + r0, t1 = t0 + 1;
            const f32x4* y0p = (const f32x4*)(Y + (size_t)t0 * D) + lane; const f32x4* y1p = (const f32x4*)(Y + (size_t)t1 * D) + lane;
            const f32x4* x0p = (const f32x4*)(x + (size_t)t0 * D) + lane; const f32x4* x1p = (const f32x4*)(x + (size_t)t1 * D) + lane;
            f32x4 v0[8], v1[8], xa[8], xb[8]; float ss0 = 0.f, ss1 = 0.f;
#pragma unroll
            for (int j = 0; j < 8; ++j) { v0[j] = y0p[64 * j]; v1[j] = y1p[64 * j]; }
#pragma unroll
            for (int j = 0; j < 8; ++j) { xa[j] = x0p[64 * j]; xb[j] = x1p[64 * j]; }
#pragma unroll
            for (int j = 0; j < 8; ++j) { ss0 += (v0[j].x * v0[j].x + v0[j].y * v0[j].y) + (v0[j].z * v0[j].z + v0[j].w * v0[j].w); ss1 += (v1[j].x * v1[j].x + v1[j].y * v1[j].y) + (v1[j].z * v1[j].z + v1[j].w * v1[j].w); }
            ss0 = wave_sum(ss0); ss1 = wave_sum(ss1);
            const float rs0 = 1.0f / sqrtf(ss0 * (1.0f / D) + EPS), rs1 = 1.0f / sqrtf(ss1 * (1.0f / D) + EPS);
            float q0 = 0.f, q1 = 0.f;
#pragma unroll
            for (int j = 0; j < 8; ++j) { const int k = 4 * lane + 256 * j; const f32x4 A = *(const f32x4*)(ABC + k);
                const f32x4 a0 = xa[j] + A * (v0[j] * rs0), a1 = xb[j] + A * (v1[j] * rs1);
                *(f32x4*)(X1 + (size_t)t0 * D + k) = a0; *(f32x4*)(X1 + (size_t)t1 * D + k) = a1; v0[j] = a0; v1[j] = a1;
                q0 += (a0.x * a0.x + a0.y * a0.y) + (a0.z * a0.z + a0.w * a0.w); q1 += (a1.x * a1.x + a1.y * a1.y) + (a1.z * a1.z + a1.w * a1.w); }
            q0 = wave_sum(q0); q1 = wave_sum(q1);
            const float rt0 = 1.0f / sqrtf(q0 * (1.0f / D) + EPS), rt1 = 1.0f / sqrtf(q1 * (1.0f / D) + EPS);
#pragma unroll
            for (int j = 0; j < 8; ++j) { const int k = 4 * lane + 256 * j; const f32x4 B = *(const f32x4*)(ABC + 2048 + k), C = *(const f32x4*)(ABC + 4096 + k);
                const f32x4 h0 = (v0[j] * rt0) * B + C, h1 = (v1[j] * rt1) * B + C;
                *(v2u*)(HN + (size_t)t0 * D + k) = pk4(h0); *(v2u*)(HN + (size_t)t1 * D + k) = pk4(h1);
                *(LAS f32x4*)(H2 + r0 * HP + k) = h0; *(LAS f32x4*)(H2 + (r0 + 1) * HP + k) = h1; }
        }
        __syncthreads();
        {
            const int g = lane >> 4, i = lane & 15;
            f32x4 lacc[5];
#pragma unroll
            for (int nt = 0; nt < 5; ++nt) lacc[nt] = (f32x4){0.f, 0.f, 0.f, 0.f};
            const LAS float* ap = H2 + i * HP + 256 * wave + 8 * g;
            const int wu = __builtin_amdgcn_readfirstlane(wave);
            v4u bq0[10], bq1[10];
#define LG_LOAD(set_, blk_) do { _Pragma("unroll") for (int f_ = 0; f_ < 10; ++f_) set_[f_] = __builtin_amdgcn_raw_buffer_load_b128(rW, lane * 16, ((wu * 8 + (blk_)) * 10 + f_) * 1024, 0); } while (0)
#define LG_STEP(set_, blk_) do { const f32x4 av0 = *(const LAS f32x4*)(ap + 32 * (blk_)), av1 = *(const LAS f32x4*)(ap + 32 * (blk_) + 4); \
                v4u ahi, alo; unsigned* hp = (unsigned*)&ahi; unsigned* lp = (unsigned*)&alo; \
                { const unsigned h = pk2(av0.x, av0.y); hp[0] = h; lp[0] = pk2(av0.x - bf2f(h & 0xffffu), av0.y - bf2f(h >> 16)); } \
                { const unsigned h = pk2(av0.z, av0.w); hp[1] = h; lp[1] = pk2(av0.z - bf2f(h & 0xffffu), av0.w - bf2f(h >> 16)); } \
                { const unsigned h = pk2(av1.x, av1.y); hp[2] = h; lp[2] = pk2(av1.x - bf2f(h & 0xffffu), av1.y - bf2f(h >> 16)); } \
                { const unsigned h = pk2(av1.z, av1.w); hp[3] = h; lp[3] = pk2(av1.z - bf2f(h & 0xffffu), av1.w - bf2f(h >> 16)); } \
                const bf16x8 fah = __builtin_bit_cast(bf16x8, ahi), fal = __builtin_bit_cast(bf16x8, alo); \
                _Pragma("unroll") for (int nt = 0; nt < 5; ++nt) { const bf16x8 fbh = __builtin_bit_cast(bf16x8, set_[2 * nt]), fbl = __builtin_bit_cast(bf16x8, set_[2 * nt + 1]); \
                    lacc[nt] = MFMA16(fal, fbh, lacc[nt]); lacc[nt] = MFMA16(fah, fbl, lacc[nt]); lacc[nt] = MFMA16(fah, fbh, lacc[nt]); } } while (0)
            LG_LOAD(bq0, 0);
#pragma unroll
            for (int b2 = 0; b2 < 4; ++b2) {
                LG_LOAD(bq1, 2 * b2 + 1); LG_STEP(bq0, 2 * b2); __builtin_amdgcn_sched_barrier(0);
                if (b2 < 3) LG_LOAD(bq0, 2 * b2 + 2);
                LG_STEP(bq1, 2 * b2 + 1); __builtin_amdgcn_sched_barrier(0);
            }
#undef LG_LOAD
#undef LG_STEP
            __syncthreads();
            LAS float* PART = H2 + wave * (16 * 80);
#pragma unroll
            for (int nt = 0; nt < 5; ++nt)
#pragma unroll
                for (int r = 0; r < 4; ++r) PART[(4 * g + r) * 80 + 16 * nt + i] = lacc[nt][r];
            __syncthreads();
            for (int idx = tid; idx < 16 * 80; idx += NTHR) { float s = 0.f;
#pragma unroll
                for (int w = 0; w < 8; ++w) s += H2[w * (16 * 80) + idx];
                const int n = idx % 80; s += (n < 64) ? bexp[n] : ((n < 72) ? bgrp[n - 64] : 0.f); LG[idx] = s; }
        }
        __syncthreads();
        if (tid < 16) {
            const int r = tid, t = base + r; const LAS float* lg = LG + r * 80;
            int gi = 0; float gm = lg[64];
#pragma unroll
            for (int j = 1; j < 8; ++j) { const float v = lg[64 + j]; if (v > gm) { gm = v; gi = j; } }
            float gs = 0.f;
#pragma unroll
            for (int j = 0; j < 8; ++j) gs += expf(lg[64 + j] - gm);
            const float gprob = 1.0f / gs;
            int i0 = 0; float v0 = lg[gi * 8];
#pragma unroll
            for (int j = 1; j < 8; ++j) { const float v = lg[gi * 8 + j]; if (v > v0) { v0 = v; i0 = j; } }
            int i1 = -1; float v1 = -INFINITY;
#pragma unroll
            for (int j = 0; j < 8; ++j) { const float v = lg[gi * 8 + j]; if (j != i0 && v > v1) { v1 = v; i1 = j; } }
            const float e1 = expf(v1 - v0); const float w0 = gprob / (1.0f + e1), w1 = gprob * e1 / (1.0f + e1);
            const int ex0 = gi * 8 + i0, ex1 = gi * 8 + i1;
            RW[2 * t] = w0; RW[2 * t + 1] = w1;
            rex[(npass * 16 + r) * 2] = ex0; rex[(npass * 16 + r) * 2 + 1] = ex1;
        }
        __syncthreads();
        ++npass;
    }
    {
        const int nasg = npass * 32;
        LAS int* lbase = rex + 2048;
        unsigned* CNT = (unsigned*)(ws + WS_CTL) + CW_CNT; int* LISTS = (int*)(ws + WS_LISTS);
        if (tid < NEXP) { int c = 0; for (int q = 0; q < nasg; ++q) c += (rex[q] == tid) ? 1 : 0;
            lbase[tid] = c ? (int)__hip_atomic_fetch_add(CNT + tid * 32, (unsigned)c, __ATOMIC_RELAXED, __HIP_MEMORY_SCOPE_AGENT) : 0; }
        __syncthreads();
        for (int j = tid; j < nasg; j += NTHR) { const int ej = rex[j]; int rk = 0; for (int q = 0; q < j; ++q) rk += (rex[q] == ej) ? 1 : 0;
            const int pass = j >> 5, r = (j >> 1) & 15, k = j & 1; const int t = ((int)blockIdx.x + pass * (int)gridDim.x) * 16 + r;
            LISTS[(size_t)ej * LCAP + lbase[ej] + rk] = 2 * t + k; }
        __syncthreads();
    }
}

constexpr int XG_RM = 256, XG_AP = 160, XG_BP = 272, XG_ABYTES = XG_RM * XG_AP, XG_BBYTES = 64 * XG_BP, XG_BUF = XG_ABYTES + XG_BBYTES;
static_assert(2 * XG_BUF <= 147456 - 2048, "expert GEMM LDS");
__device__ __forceinline__ int wave_iscan(int v, int lane) {
#pragma unroll
    for (int d = 1; d < 64; d <<= 1) { const int t = __shfl_up(v, d); if (lane >= d) v += t; }
    return v; }
__device__ __forceinline__ void expert_offsets(const unsigned* CNT, LAS int* cnts  , LAS int* offs  , LAS int* eptab  , int rm, int tid) {
    if (tid < NEXP) { const int lane = tid, c = (int)__hip_atomic_load(CNT + tid * 32, RLX_AGENT); const int np = (c + rm - 1) / rm;
        const int ic = wave_iscan(c, lane);
        cnts[lane] = c; offs[lane] = ic - c; if (lane == NEXP - 1) offs[NEXP] = ic;
        const int n2 = (np == 2) ? 2 : 0, n3 = (np >= 3) ? np : 0, n1 = (np == 1) ? 1 : 0;
        const int i2 = wave_iscan(n2, lane), i3 = wave_iscan(n3, lane), i1 = wave_iscan(n1, lane);
        const int t2 = __shfl(i2, 63), t3 = __shfl(i3, 63), t1 = __shfl(i1, 63);
        const int pos = (np == 2) ? (i2 - n2) : (np >= 3) ? (t2 + i3 - n3) : (t2 + t3 + i1 - n1);
        for (int p = 0; p < np; ++p) eptab[pos + p] = lane | (p << 8);
        if (lane == 0) eptab[191] = t2 + t3 + t1; }
    __syncthreads();
}
template <bool UP>
__device__ __forceinline__ void xgemm_unit(const Args& a, LAS unsigned char* lds, int e, int s, int cnt, int off_e, int rp, int tid, int lane, int wave) {
    unsigned char* ws = a.ws;
    constexpr int K = UP ? D : DE, NK = K / 64, LDB = UP ? DE : D;
    const int* LISTS = (const int*)(ws + WS_LISTS) + (size_t)e * LCAP; const float* RW = (const float*)(ws + WS_ROUTE + 65536);
    const bf16* Abase = UP ? (const bf16*)(ws + WS_HN) : (const bf16*)(ws + WS_HG);
    bf16* HG = (bf16*)(ws + WS_HG); bf16* YA = (bf16*)(ws + WS_YA);
    const bool loader = wave < 4;
    const int cw = wave & 3;
    {
        const int nrows = (cnt - rp < XG_RM) ? (cnt - rp) : XG_RM;
        if (loader) {
            const int tl = tid & 255;
            const int arow = tl >> 3, ach = tl & 7;
            const int n4 = UP ? (tl & 15) : (tl & 31), kr = UP ? ((tl >> 4) & 7) : (tl >> 5), bcol = UP ? (64 * ((wave >> 1) & 1) + 4 * n4) : 4 * n4;
            const float* Bu = UP ? ((((wave >> 1) & 1) ? a.in[I_W3] : a.in[I_W1]) + (size_t)e * D * DE) : (a.in[I_W2] + (size_t)e * DE * D);
            const __amdgpu_buffer_rsrc_t rB = __builtin_amdgcn_make_buffer_rsrc((void*)Bu, (short)0, K * LDB * 4, 0x00020000);
            const __amdgpu_buffer_rsrc_t rA = __builtin_amdgcn_make_buffer_rsrc((void*)Abase, (short)0, UP ? T * D * 2 : 2 * T * DE * 2, 0x00020000);
            const unsigned boff = (unsigned)(kr * LDB + 4 * n4 + (UP ? 64 : 128) * s) * 4u;
            const int bdst = XG_ABYTES + kr * XG_BP + bcol * 2;
            unsigned aoff[8];
#pragma unroll
            for (int j = 0; j < 8; ++j) { int rr = arow + 32 * j; rr = (rr < nrows) ? rr : (nrows - 1);
                if (UP) aoff[j] = ((unsigned)(LISTS[rp + rr] >> 1) * (unsigned)D + ach * 8) * 2u; else aoff[j] = ((unsigned)(off_e + rp + rr) * (unsigned)DE + ach * 8) * 2u; }
            f32x4 pb0[8], pb1[8], pb2[8]; v4u pa0[8], pa1[8], pa2[8];
            static_assert(NK % 3 == 2, "loader ring schedule");
#define XG_ISSUE_B(pb_, t_) do { _Pragma("unroll") for (int j_ = 0; j_ < 8; ++j_) pb_[j_] = __builtin_bit_cast(f32x4, __builtin_amdgcn_raw_buffer_load_b128(rB, boff, (64 * (t_) + 8 * j_) * LDB * 4, 0)); } while (0)
#define XG_ISSUE_A(pa_, t_) do { _Pragma("unroll") for (int j_ = 0; j_ < 8; ++j_) pa_[j_] = __builtin_amdgcn_raw_buffer_load_b128(rA, aoff[j_], 128 * (t_), 0); } while (0)
#define XG_STORE(pb_, pa_, bo_) do { _Pragma("unroll") for (int j_ = 0; j_ < 8; ++j_) *(LAS v2u*)(lds + (bo_) + bdst + 8 * j_ * XG_BP) = pk4(pb_[j_]); \
            _Pragma("unroll") for (int j_ = 0; j_ < 8; ++j_) *(LAS v4u*)(lds + (bo_) + (arow + 32 * j_) * XG_AP + ach * 16) = pa_[j_]; } while (0)
#define XG_STEP(t_, PBN, PAN, PBS, PAS) do { XG_ISSUE_A(PAN, (t_) + 2); { const int tb_ = ((t_) + 3 < NK) ? (t_) + 3 : NK - 1; XG_ISSUE_B(PBN, tb_); } \
                XG_STORE(PBS, PAS, (((t_) + 1) & 1) * XG_BUF); __syncthreads(); } while (0)
            XG_ISSUE_A(pa0, 0); XG_ISSUE_B(pb0, 0); XG_ISSUE_A(pa1, 1); XG_ISSUE_B(pb1, 1); XG_ISSUE_B(pb2, 2);
            XG_STORE(pb0, pa0, 0);
            __syncthreads();
#pragma unroll
            for (int t = 0; t + 3 <= NK - 2; t += 3) {
                XG_STEP(t, pb0, pa2, pb1, pa1);
                XG_STEP(t + 1, pb1, pa0, pb2, pa2);
                XG_STEP(t + 2, pb2, pa1, pb0, pa0);
            }
            XG_STORE(pb1, pa1, ((NK - 1) & 1) * XG_BUF); __syncthreads();
            __syncthreads();
#undef XG_ISSUE_A
#undef XG_ISSUE_B
#undef XG_STEP
#undef XG_STORE
        } else {
            const int g = lane >> 4, i = lane & 15, q4 = (lane >> 2) & 3, p4 = lane & 3;
            f32x4 acc[4][8];
#pragma unroll
            for (int mi = 0; mi < 4; ++mi)
#pragma unroll
                for (int nt = 0; nt < 8; ++nt) acc[mi][nt] = (f32x4){0.f, 0.f, 0.f, 0.f};
            LAS int* rinfo = (LAS int*)(lds + 2 * XG_BUF + 2048) + cw * 128;
            if (!UP) { const int row_ = 64 * cw + lane; int as_ = 0; float w_ = 0.f; if (row_ < nrows) { as_ = LISTS[rp + row_]; w_ = RW[as_]; } rinfo[2 * lane] = as_; rinfo[2 * lane + 1] = __float_as_int(w_); }
#define XG_LDA(dst_, bo_, ks_) do { _Pragma("unroll") for (int mi_ = 0; mi_ < 4; ++mi_) dst_[mi_] = *(const LAS bf16x8*)(lds + (bo_) + (16 * (4 * cw + mi_) + i) * XG_AP + (32 * (ks_) + 8 * g) * 2); } while (0)
#define XG_LDB(dst_, bo_, ks_, nh_) do { _Pragma("unroll") for (int nt_ = 0; nt_ < 4; ++nt_) dst_[nt_] = cat8(tr16(lds + (bo_) + XG_ABYTES + (32 * (ks_) + 8 * g + q4) * XG_BP + (16 * (4 * (nh_) + nt_) + 4 * p4) * 2), tr16(lds + (bo_) + XG_ABYTES + (32 * (ks_) + 8 * g + 4 + q4) * XG_BP + (16 * (4 * (nh_) + nt_) + 4 * p4) * 2)); } while (0)
#define XG_MM(a_, b_, nh_) do { _Pragma("unroll") for (int mi_ = 0; mi_ < 4; ++mi_) _Pragma("unroll") for (int nt_ = 0; nt_ < 4; ++nt_) acc[mi_][4 * (nh_) + nt_] = MFMA16(a_[mi_], b_[nt_], acc[mi_][4 * (nh_) + nt_]); } while (0)
#define XG_COMPUTE(bo_) do { bf16x8 fa0_[4], fb0_[4], fb1_[4]; \
                XG_LDA(fa0_, bo_, 0); XG_LDB(fb0_, bo_, 0, 0); __builtin_amdgcn_sched_barrier(0); \
                XG_LDB(fb1_, bo_, 0, 1); XG_MM(fa0_, fb0_, 0); __builtin_amdgcn_sched_barrier(0); \
                XG_LDB(fb0_, bo_, 1, 0); XG_MM(fa0_, fb1_, 1); __builtin_amdgcn_sched_barrier(0); \
                XG_LDA(fa0_, bo_, 1); XG_LDB(fb1_, bo_, 1, 1); XG_MM(fa0_, fb0_, 0); __builtin_amdgcn_sched_barrier(0); \
                XG_MM(fa0_, fb1_, 1); } while (0)
            __syncthreads();
#pragma unroll 1
            for (int t = 0; t < NK; t += 2) {
                XG_COMPUTE(0);
                __syncthreads();
                XG_COMPUTE(XG_BUF);
                __syncthreads();
            }
#undef XG_COMPUTE
#undef XG_LDA
#undef XG_LDB
#undef XG_MM
            {
                const bool odd = (i & 1) != 0;
                if (UP) {
                    LAS unsigned char* stg = lds + XG_BUF + cw * 9216;
#pragma unroll
                    for (int mi = 0; mi < 4; ++mi)
#pragma unroll
                        for (int r = 0; r < 4; ++r) { const int lrow = 16 * mi + 4 * g + r;
#pragma unroll
                            for (int q = 0; q < 2; ++q) { const float a0 = siluf(acc[mi][2 * q][r]) * acc[mi][2 * q + 4][r], a1 = siluf(acc[mi][2 * q + 1][r]) * acc[mi][2 * q + 5][r];
                                const float got = swap1(odd ? a0 : a1);
                                const unsigned pk = odd ? pk2(got, a1) : pk2(a0, got);
                                const int col = odd ? (16 * (2 * q + 1) + i - 1) : (16 * (2 * q) + i);
                                *(LAS unsigned*)(stg + lrow * 144 + col * 2) = pk; } }
#pragma unroll
                    for (int jj = 0; jj < 8; ++jj) { const int lrow = (lane >> 3) + 8 * jj, c = lane & 7, row = 64 * cw + lrow;
                        const v4u o = *(const LAS v4u*)(stg + lrow * 144 + 16 * c);
                        if (row < nrows) *(v4u*)(HG + (size_t)(off_e + rp + row) * DE + 64 * s + 8 * c) = o; }
                } else {
                    LAS unsigned char* stg = lds + XG_BUF + cw * 8704;
#pragma unroll
                    for (int h = 0; h < 2; ++h) {
#pragma unroll
                        for (int m2 = 0; m2 < 2; ++m2)
#pragma unroll
                            for (int r = 0; r < 4; ++r) { const int mi = 2 * h + m2, lrow = 16 * m2 + 4 * g + r; const float w = __int_as_float(rinfo[2 * (16 * mi + 4 * g + r) + 1]);
#pragma unroll
                                for (int q = 0; q < 4; ++q) { const float a0 = acc[mi][2 * q][r] * w, a1 = acc[mi][2 * q + 1][r] * w;
                                    const float got = swap1(odd ? a0 : a1);
                                    const unsigned pk = odd ? pk2(got, a1) : pk2(a0, got);
                                    const int col = odd ? (16 * (2 * q + 1) + i - 1) : (16 * (2 * q) + i);
                                    *(LAS unsigned*)(stg + lrow * 272 + col * 2) = pk; } }
#pragma unroll
                        for (int jj = 0; jj < 8; ++jj) { const int lrow = (lane >> 4) + 4 * jj, c = lane & 15, row = 64 * cw + 32 * h + lrow;
                            const v4u o = *(const LAS v4u*)(stg + lrow * 272 + 16 * c);
                            if (row < nrows) { const int as = rinfo[2 * (32 * h + lrow)]; *(v4u*)(YA + (size_t)as * D + 128 * s + 8 * c) = o; } }
                    }
                }
            }
        }
    }
}
template <bool UP>
__device__ __forceinline__ void xgemm_phase(const Args& a, LAS unsigned char* lds, int tid, int lane, int wave) {
    LAS int* cnts = (LAS int*)(lds + 2 * XG_BUF); LAS int* offs = cnts + 64; LAS int* eptab = offs + 68;
    expert_offsets((const unsigned*)(a.ws + WS_CTL) + CW_CNT, cnts, offs, eptab, XG_RM, tid);
    const int G = gridDim.x, bx = blockIdx.x; const int vcu = (G % 8 == 0) ? (bx % 8) * (G / 8) + bx / 8 : bx;
    constexpr int SH = UP ? 3 : 4;
    const int nitem = __builtin_amdgcn_readfirstlane(eptab[191]) << SH;
    for (int u = vcu; u < nitem; u += G) { const int ep = __builtin_amdgcn_readfirstlane(eptab[u >> SH]); const int e = ep & 255, rp = (ep >> 8) * XG_RM, s = u & ((1 << SH) - 1);
        xgemm_unit<UP>(a, lds, e, s, __builtin_amdgcn_readfirstlane(cnts[e]), __builtin_amdgcn_readfirstlane(offs[e]), rp, tid, lane, wave); }
}

__device__ __forceinline__ void phase11(const Args& a, int lane, int wave) {
    unsigned char* ws = a.ws;
    const float* MODF = (const float*)(ws + WS_MODF); const float* X1 = (const float*)(ws + WS_X1); const bf16* YA = (const bf16*)(ws + WS_YA); const float* g = a.in[I_GPOSTFFN];
    const int gw = blockIdx.x * NWAVES + wave, NGW = gridDim.x * NWAVES;
    v2u ya0[8], ya1[8], yb0[8], yb1[8]; f32x4 xa[8], xb[8];
#define P11_LOAD(y0_, y1_, x_, t_) do { _Pragma("unroll") for (int j_ = 0; j_ < 8; ++j_) { const int k_ = 4 * lane + 256 * j_; \
        y0_[j_] = *(const v2u*)(YA + (size_t)(2 * (t_)) * D + k_); y1_[j_] = *(const v2u*)(YA + (size_t)(2 * (t_) + 1) * D + k_); x_[j_] = *(const f32x4*)(X1 + (size_t)(t_) * D + k_); } } while (0)
#define P11_ROW(y0_, y1_, x_, t_) do { f32x4 v_[8]; float ss_ = 0.f; \
        _Pragma("unroll") for (int j_ = 0; j_ < 8; ++j_) { const v2u p_ = y0_[j_], q_ = y1_[j_]; \
            v_[j_].x = bf2f(p_.x & 0xffffu) + bf2f(q_.x & 0xffffu); v_[j_].y = bf2f(p_.x >> 16) + bf2f(q_.x >> 16); v_[j_].z = bf2f(p_.y & 0xffffu) + bf2f(q_.y & 0xffffu); v_[j_].w = bf2f(p_.y >> 16) + bf2f(q_.y >> 16); \
            ss_ += (v_[j_].x * v_[j_].x + v_[j_].y * v_[j_].y) + (v_[j_].z * v_[j_].z + v_[j_].w * v_[j_].w); } \
        ss_ = wave_sum(ss_); const float rstd_ = 1.0f / sqrtf(ss_ * (1.0f / D) + EPS); \
        _Pragma("unroll") for (int j_ = 0; j_ < 8; ++j_) { const int k_ = 4 * lane + 256 * j_; \
            const f32x4 gv_ = *(const f32x4*)(g + k_), gt_ = *(const f32x4*)(MODF + 5 * 2048 + k_); \
            *(f32x4*)(a.out + (size_t)(t_) * D + k_) = x_[j_] + gt_ * ((v_[j_] * rstd_) * gv_); } } while (0)
    int t = gw;
    if (t < T) P11_LOAD(ya0, ya1, xa, t);
    for (; t < T; t += 2 * NGW) {
        const int t2 = t + NGW, t3 = t + 2 * NGW;
        if (t2 < T) P11_LOAD(yb0, yb1, xb, t2);
        P11_ROW(ya0, ya1, xa, t);
        if (t2 < T) { if (t3 < T) P11_LOAD(ya0, ya1, xa, t3); P11_ROW(yb0, yb1, xb, t2); }
    }
#undef P11_LOAD
#undef P11_ROW
}

#ifndef MK_N_LAUNCHES
#define MK_N_LAUNCHES 1
#endif
constexpr int N_PHASES = 12;
constexpr int N_LAUNCHES = MK_N_LAUNCHES;
constexpr int MISC_OFF = 147456 - 256;

__global__ void __launch_bounds__(NTHR, 2) fwd_kernel(Args args) {
    extern __shared__ __attribute__((aligned(16))) unsigned char lds_raw[];
    LAS unsigned char* lds = (LAS unsigned char*)lds_raw;
    const int tid = threadIdx.x, lane = tid & 63, wave = __builtin_amdgcn_readfirstlane(tid >> 6);
    volatile LAS unsigned* MISC = (volatile LAS unsigned*)(lds + MISC_OFF);
    if (tid < 64) MISC[tid] = 0u;
    __syncthreads();
    unsigned char* ws = args.ws;
    unsigned* ctl = (unsigned*)(ws + WS_CTL);
    XcdBarrier bar; bar.bar = ctl + CW_BAR; bar.x = 0; bar.st = nullptr;
    if (N_LAUNCHES == 1) bar = xcd_barrier_post(ctl + CW_BAR, MISC + 8);
    const int lo = args.ph_lo, hi = args.ph_hi;
#ifndef ONLYP
#define ONLYP -1
#endif
#define IN(k) ((ONLYP < 0) ? (lo <= (k) && (k) < hi) : ((k) == ONLYP))
#define SEAM(k) do { if (IN(k) && IN((k) + 1)) xcd_barrier(bar); } while (0)
    if (IN(0)) { phase0<0>(args, lds, tid, lane, wave, (int)blockIdx.x * NWAVES + wave, (int)gridDim.x * NWAVES); } SEAM(0);
    if (IN(1)) { phase1(args, lds, tid, lane, wave); } SEAM(1);
    if (IN(2)) {
        pg8::Gemm g{(const pg8::bf16_t*)(ws + WS_HN), (const pg8::bf16_t*)(ws + WS_WINT), T, NIN, D};
        pg8::StaticOrder S; S.init(T, NIN, gridDim.x, (int)blockIdx.x);
        EpiIn E{(bf16*)(ws + WS_QA), (bf16*)(ws + WS_KA), (bf16*)(ws + WS_VA), (bf16*)(ws + WS_MQ0), (bf16*)(ws + WS_MK0), (bf16*)(ws + WS_MV), (bf16*)(ws + WS_MO), (const float*)(ws + WS_COS), (const float*)(ws + WS_SIN)};
        if ((int)blockIdx.x >= (int)gridDim.x - 4) gate_prep(args, lds, (int)blockIdx.x - ((int)gridDim.x - 4), tid, lane, wave);
        pg8::gemm_phase<EpiIn, pg8::StaticOrder, true, true>(lds, g, S, E);
        { const int G_ = (int)gridDim.x, rem_ = (704 % G_), first_ = (rem_ == 0) ? 0 : rem_, nl_ = G_ - first_;
          if ((int)blockIdx.x >= first_) { __syncthreads(); phase0<1>(args, lds, tid, lane, wave, ((int)blockIdx.x - first_) * NWAVES + wave, nl_ * NWAVES); } }
    } SEAM(2);
    if (IN(3)) {
        conv_phase(args, tid);
        for (int it = blockIdx.x; it < 128 * 4; it += gridDim.x) attn_item(args, lds, it >> 2, it & 3, tid, lane, wave);
    } SEAM(3);
    if (IN(4)) {
        for (int it = blockIdx.x; it < 12 * (NSEG - 1); it += gridDim.x) { const int hh_ = it / (3 * (NSEG - 1)), eh_ = (it / (NSEG - 1)) % 3, sg_ = it % (NSEG - 1);
            if (eh_ == 2) mlstm_item<true, true>(args, lds, hh_, eh_, sg_, tid, lane, wave); else mlstm_item<true, false>(args, lds, hh_, eh_, sg_, tid, lane, wave); }
        xcd_barrier(bar);
        for (int it = blockIdx.x; it < 12 * NSEG; it += gridDim.x) { const int hh_ = it / (3 * NSEG), eh_ = (it / NSEG) % 3, sg_ = it % NSEG;
            if (eh_ == 2) mlstm_item<false, true>(args, lds, hh_, eh_, sg_, tid, lane, wave); else mlstm_item<false, false>(args, lds, hh_, eh_, sg_, tid, lane, wave); }
    } SEAM(4);
    if (IN(5)) { mlstm_norm_phase(args, lane, wave); } SEAM(5);
    if (IN(6)) {
        pg8::Gemm g{(const pg8::bf16_t*)(ws + WS_YMIX), (const pg8::bf16_t*)(ws + WS_WOUTT), T, D, D};
        pg8::StaticOrder S; S.init(T, D, gridDim.x, (int)blockIdx.x);
        EpiY E{(float*)(ws + WS_Y)};
        pg8::gemm_phase<EpiY, pg8::StaticOrder, true, true>(lds, g, S, E);
    } SEAM(6);
    if (IN(7)) { phase7(args, lds, tid, lane, wave); } if (IN(7) && IN(9)) xcd_barrier(bar);
    if (IN(9)) { xgemm_phase<true>(args, lds, tid, lane, wave); } SEAM(9);
    if (IN(10)) { xgemm_phase<false>(args, lds, tid, lane, wave); } SEAM(10);
    if (IN(11)) { phase11(args, lane, wave); }
#undef IN
#undef SEAM
}

extern "C" void kernel_launch(void* const* d_in, const int* in_sizes, int n_in, void* d_out, int out_size, void* d_ws, size_t ws_size, hipStream_t stream) {
    static int grid = 0;
    if (grid == 0) {
        if (n_in != 22 || out_size != T * D || ws_size < WS_END) { fprintf(stderr, "kernel_launch: unexpected shapes: n_in %d out %d ws %zu (need %zu)\n", n_in, out_size, ws_size, (size_t)WS_END); grid = -1; return; }
        int dev = 0, cus = 0;
        if (hipGetDevice(&dev) != hipSuccess || hipDeviceGetAttribute(&cus, hipDeviceAttributeMultiprocessorCount, dev) != hipSuccess) { grid = -1; return; }
        if (hipFuncSetAttribute((const void*)fwd_kernel, hipFuncAttributeMaxDynamicSharedMemorySize, LDS_BYTES) != hipSuccess) { fprintf(stderr, "kernel_launch: hipFuncSetAttribute failed\n"); grid = -1; return; }
        int per_cu = 0;
        if (hipOccupancyMaxActiveBlocksPerMultiprocessor(&per_cu, (const void*)fwd_kernel, NTHR, LDS_BYTES) != hipSuccess || per_cu < 1) fprintf(stderr, "kernel_launch: occupancy query says %d\n", per_cu);
        (void)hipGetLastError();
        grid = cus;
    }
    if (grid < 0) return;
    (void)hipMemsetAsync((char*)d_ws + WS_CTL, 0, CTL_ZERO_BYTES, stream);
    Args a{};
    for (int i = 0; i < 22; ++i) a.in[i] = (const float*)d_in[i];
    a.out = (float*)d_out; a.ws = (unsigned char*)d_ws;
    if (N_LAUNCHES == 1) { a.ph_lo = 0; a.ph_hi = N_PHASES; hipLaunchKernelGGL(fwd_kernel, dim3(grid), dim3(NTHR), LDS_BYTES, stream, a); }
    else for (int p = 0; p < N_PHASES; ++p) { a.ph_lo = p; a.ph_hi = p + 1; hipLaunchKernelGGL(fwd_kernel, dim3(grid), dim3(NTHR), LDS_BYTES, stream, a); }
}
```

```cpp
#include <hip/hip_runtime.h>
#include <cstdio>
#include <cstdint>
namespace pg8 {
#define PG8_LAS __attribute__((address_space(3)))
typedef unsigned short bf16_t;
typedef short bf16x8 __attribute__((ext_vector_type(8)));
typedef float f32x4 __attribute__((ext_vector_type(4)));
typedef unsigned u32x4 __attribute__((ext_vector_type(4)));
constexpr int BM = 256, BK = 64, HALF = 128, HTB = HALF * BK * 2  , STAGE_BYTES = 8 * HTB, NXCD = 8, WGM = 8;

__host__ __device__ __forceinline__ int lds_byte(int r, int c) { const int st = (r >> 4) * 2 + (c >> 5), rr = r & 15, cc = c & 31, ob = rr * 64 + cc * 2; return st * 1024 + (ob ^ (((ob >> 9) & 1) << 5)); }
__host__ __device__ __forceinline__ void stage_rc(int b, int& R, int& C) { const int st = b / 1024, sb = b % 1024, swz = sb ^ (((sb >> 9) & 1) << 5); R = (st >> 1) * 16 + swz / 64; C = (st & 1) * 32 + (swz % 64) / 2; }
__host__ __device__ __forceinline__ int perm32(int rho) { const int n = rho >> 4, i = rho & 15; return 8 * (i >> 2) + 4 * n + (i & 3); }

__device__ __forceinline__ unsigned cvt_pk_bf16(float lo, float hi) { unsigned r; asm volatile("v_cvt_pk_bf16_f32 %0, %1, %2" : "=v"(r) : "v"(lo), "v"(hi)); return r; }
struct Unit { int pm, pn; };
struct Gemm { const bf16_t* A; const bf16_t* Bt; int M, N, K; };

struct StaticOrder {
    int nM, nN, nwg, G, c;
    __host__ __device__ void init(int M, int N, int G_, int c_) { nM = M / BM; nN = N / BM; nwg = nM * nN; G = G_; c = c_; }
    __host__ __device__ bool next(int i, Unit& u) const {
        const long L = (long)i * G + c; if (L >= nwg) return false;
        int wgid = (int)L; { const int q = nwg / NXCD, r = nwg % NXCD, xcd = wgid % NXCD, off = wgid / NXCD; wgid = (xcd < r ? xcd * (q + 1) : r * (q + 1) + (xcd - r) * q) + off; }
        const int nig = WGM * nN, gid = wgid / nig, fm = gid * WGM, gsz = (nM - fm) < WGM ? (nM - fm) : WGM;
        u.pm = fm + ((wgid % nig) % gsz); u.pn = (wgid % nig) / gsz; return true;
    }
    __device__ __forceinline__ void a_ready(const Unit&) const {}
    __device__ __forceinline__ void done(const Unit&) const {}
};

template <class Epi, class Sched, bool ALIGN_EPI = false, bool SP2 = false>
__device__ __forceinline__ void gemm_phase(PG8_LAS unsigned char* lds, const Gemm g, const Sched& S, const Epi& E) {
    const int tid = threadIdx.x, wid = __builtin_amdgcn_readfirstlane(tid >> 6), lane = tid & 63, wr = wid >> 2, wc = wid & 3, fr = lane & 15, fq = lane >> 4;
    const int K = g.K, nt = K / BK;
    unsigned voffA[2], voffB[2];
#pragma unroll
    for (int i = 0; i < 2; ++i) { int R, C; stage_rc(tid * 16 + i * 8192, R, C); const int Rb = Epi::PERM ? ((R & ~31) + perm32(R & 31)) : R;
        voffA[i] = (unsigned)(R * K + C) * 2u; voffB[i] = (unsigned)(Rb * K + C) * 2u; }
    const size_t kstep = (size_t)(BK * 2);
    const size_t hstep = (size_t)HALF * K * 2;
    const size_t tstep = 2 * hstep;
    const unsigned ldsw = (unsigned)wid * 1024u;
    const int aoff = lds_byte(wr * 64 + fr, fq * 8), boff = lds_byte(wc * 32 + fr, fq * 8);
#define PG8_SA(b, h) (((b) * 2 + (h)) * HTB)
#define PG8_SB(b, h) ((4 + (b) * 2 + (h)) * HTB)
#define PG8_STAGE(bufoff, gbase, voff) do { _Pragma("unroll") for (int _i = 0; _i < 2; ++_i) \
        __builtin_amdgcn_global_load_lds((const unsigned*)((const char*)(gbase) + (voff)[_i]), (PG8_LAS unsigned*)(lds + (bufoff) + ldsw + _i * 8192), 16, 0, 0); } while (0)
#define PG8_LDA(dst, b, h) do { _Pragma("unroll") for (int m = 0; m < 4; ++m) _Pragma("unroll") for (int k = 0; k < 2; ++k) dst[m][k] = *(const PG8_LAS bf16x8*)(lds + PG8_SA(b, h) + aoff + m * 2048 + k * 1024); } while (0)
#define PG8_LDB(dst, b, h) do { _Pragma("unroll") for (int n = 0; n < 2; ++n) _Pragma("unroll") for (int k = 0; k < 2; ++k) dst[n][k] = *(const PG8_LAS bf16x8*)(lds + PG8_SB(b, h) + boff + n * 2048 + k * 1024); } while (0)
#define PG8_MMA(ai, bj, At, Bt) do { __builtin_amdgcn_s_setprio(1); _Pragma("unroll") for (int m = 0; m < 4; ++m) _Pragma("unroll") for (int n = 0; n < 2; ++n) _Pragma("unroll") for (int k = 0; k < 2; ++k) \
        acc[ai][bj][m][n] = __builtin_amdgcn_mfma_f32_16x16x32_bf16(Bt[n][k], At[m][k], acc[ai][bj][m][n], 0, 0, 0); __builtin_amdgcn_s_setprio(0); } while (0)
#define PG8_WAIT_V(n) asm volatile("s_waitcnt vmcnt(" #n ")" ::: "memory")
#define PG8_WAIT_L(n) asm volatile("s_waitcnt lgkmcnt(" #n ")" ::: "memory")
#define PG8_BAR __builtin_amdgcn_s_barrier()
#define PG8_SCHED __builtin_amdgcn_sched_barrier(0)
    Unit cur, nxt; int ui = 0;
    if (!S.next(0, cur)) return;
    f32x4 acc[2][2][4][2];
#pragma unroll
    for (int a = 0; a < 2; ++a)
#pragma unroll
        for (int b = 0; b < 2; ++b)
#pragma unroll
            for (int m = 0; m < 4; ++m)
#pragma unroll
                for (int n = 0; n < 2; ++n) acc[a][b][m][n] = (f32x4){0.f, 0.f, 0.f, 0.f};
    bf16x8 At[4][2], B0[2][2], B1[2][2];
    const char* cA = (const char*)g.A + (size_t)cur.pm * tstep; const char* cB = (const char*)g.Bt + (size_t)cur.pn * tstep;
    S.a_ready(cur);
    if constexpr (SP2) {
        PG8_STAGE(PG8_SB(0, 0), cB, voffB); PG8_STAGE(PG8_SB(0, 1), cB + hstep, voffB); PG8_STAGE(PG8_SA(0, 0), cA, voffA); PG8_STAGE(PG8_SA(0, 1), cA + hstep, voffA);
        if (wr == 1) PG8_BAR;
        PG8_WAIT_V(2); PG8_BAR;
        PG8_STAGE(PG8_SB(1, 0), cB + kstep, voffB); PG8_STAGE(PG8_SA(1, 0), cA + kstep, voffA); PG8_STAGE(PG8_SB(1, 1), cB + hstep + kstep, voffB);
        PG8_WAIT_V(6); PG8_BAR;
    } else {
        PG8_STAGE(PG8_SB(0, 0), cB, voffB); PG8_STAGE(PG8_SA(0, 0), cA, voffA); PG8_STAGE(PG8_SB(0, 1), cB + hstep, voffB); PG8_STAGE(PG8_SA(0, 1), cA + hstep, voffA);
        if (wr == 1) PG8_BAR;
        PG8_WAIT_V(4); PG8_BAR;
        PG8_STAGE(PG8_SB(1, 0), cB + kstep, voffB); PG8_STAGE(PG8_SA(1, 0), cA + kstep, voffA); PG8_STAGE(PG8_SB(1, 1), cB + hstep + kstep, voffB);
        PG8_WAIT_V(6); PG8_BAR;
    }
    for (;;) {
        const bool has_next = S.next(ui + 1, nxt);
        const char* nA = has_next ? (const char*)g.A + (size_t)nxt.pm * tstep : cA; const char* nB = has_next ? (const char*)g.Bt + (size_t)nxt.pn * tstep : cB;
        for (int t = 0; t < nt; t += 2) {
            const bool last = (t == nt - 2);
            const char* a1 = cA + (size_t)(t + 1) * kstep;
            const char* a2 = last ? nA : cA + (size_t)(t + 2) * kstep; const char* b2 = last ? nB : cB + (size_t)(t + 2) * kstep;
            const char* a3 = a2 + kstep; const char* b3 = b2 + kstep;
            if (last && has_next) S.a_ready(nxt);
            if constexpr (SP2) {
            PG8_LDB(B0, 0, 0); PG8_LDB(B1, 0, 1); PG8_SCHED; PG8_LDA(At, 0, 0); PG8_STAGE(PG8_SA(1, 1), a1 + hstep, voffA);
            PG8_WAIT_V(8); PG8_WAIT_L(0); PG8_BAR; PG8_MMA(0, 0, At, B0); PG8_MMA(0, 1, At, B1); PG8_BAR; PG8_SCHED;
            PG8_LDA(At, 0, 1); PG8_STAGE(PG8_SB(0, 0), b2, voffB); PG8_STAGE(PG8_SB(0, 1), b2 + hstep, voffB); PG8_STAGE(PG8_SA(0, 0), a2, voffA);
            PG8_WAIT_V(8); PG8_WAIT_L(0); PG8_BAR; PG8_MMA(1, 0, At, B0); PG8_MMA(1, 1, At, B1); PG8_BAR; PG8_SCHED;
            PG8_LDB(B0, 1, 0); PG8_LDB(B1, 1, 1); PG8_SCHED; PG8_LDA(At, 1, 0); PG8_STAGE(PG8_SA(0, 1), a2 + hstep, voffA);
            PG8_WAIT_V(8); PG8_WAIT_L(0); PG8_BAR; PG8_MMA(0, 0, At, B0); PG8_MMA(0, 1, At, B1); PG8_BAR; PG8_SCHED;
            PG8_LDA(At, 1, 1); PG8_STAGE(PG8_SB(1, 0), b3, voffB); PG8_STAGE(PG8_SB(1, 1), b3 + hstep, voffB); PG8_STAGE(PG8_SA(1, 0), a3, voffA);
            PG8_WAIT_V(8); PG8_WAIT_L(0); PG8_BAR; PG8_MMA(1, 0, At, B0); PG8_MMA(1, 1, At, B1); PG8_BAR; PG8_SCHED;
            } else {
            PG8_LDB(B0, 0, 0); PG8_SCHED; PG8_LDA(At, 0, 0); PG8_STAGE(PG8_SA(1, 1), a1 + hstep, voffA);
            PG8_WAIT_L(8); PG8_BAR; PG8_WAIT_L(0); PG8_MMA(0, 0, At, B0); PG8_BAR; PG8_SCHED;
            PG8_LDB(B1, 0, 1); PG8_STAGE(PG8_SB(0, 0), b2, voffB);
            PG8_BAR; PG8_WAIT_L(0); PG8_MMA(0, 1, At, B1); PG8_BAR;
            PG8_LDA(At, 0, 1); PG8_STAGE(PG8_SA(0, 0), a2, voffA);
            PG8_BAR; PG8_WAIT_L(0); PG8_MMA(1, 0, At, B0); PG8_BAR; PG8_SCHED;
            PG8_STAGE(PG8_SB(0, 1), b2 + hstep, voffB);
            PG8_WAIT_V(6); PG8_BAR; PG8_MMA(1, 1, At, B1); PG8_BAR;
            PG8_LDB(B0, 1, 0); PG8_SCHED; PG8_LDA(At, 1, 0); PG8_STAGE(PG8_SA(0, 1), a2 + hstep, voffA);
            PG8_WAIT_L(8); PG8_BAR; PG8_WAIT_L(0); PG8_MMA(0, 0, At, B0); PG8_BAR; PG8_SCHED;
            PG8_LDB(B1, 1, 1); PG8_STAGE(PG8_SB(1, 0), b3, voffB);
            PG8_BAR; PG8_WAIT_L(0); PG8_MMA(0, 1, At, B1); PG8_BAR;
            PG8_LDA(At, 1, 1); PG8_STAGE(PG8_SA(1, 0), a3, voffA);
            PG8_BAR; PG8_WAIT_L(0); PG8_MMA(1, 0, At, B0); PG8_BAR; PG8_SCHED;
            PG8_STAGE(PG8_SB(1, 1), b3 + hstep, voffB);
            PG8_WAIT_V(6); PG8_BAR; PG8_MMA(1, 1, At, B1); PG8_BAR;
            }
        }
        if constexpr (ALIGN_EPI) { if (wr == 0) PG8_BAR; }
        if constexpr (!Epi::AFTER_DRAIN) { E(acc, cur, wr, wc, fr, fq); S.done(cur); }
        if (!has_next) break;
#pragma unroll
        for (int a = 0; a < 2; ++a)
#pragma unroll
            for (int b = 0; b < 2; ++b)
#pragma unroll
                for (int m = 0; m < 4; ++m)
#pragma unroll
                    for (int n = 0; n < 2; ++n) acc[a][b][m][n] = (f32x4){0.f, 0.f, 0.f, 0.f};
        cur = nxt; cA = nA; cB = nB; ++ui;
        if constexpr (ALIGN_EPI) { if (wr == 1) PG8_BAR; }
    }
    PG8_WAIT_V(0);
    if constexpr (!ALIGN_EPI) { if (wr == 0) PG8_BAR; }
    PG8_BAR;
    if constexpr (Epi::AFTER_DRAIN) { E.fused(acc, cur, wr, wc, fr, fq, lds, wid, lane); S.done(cur); }
#undef PG8_SA
#undef PG8_SB
#undef PG8_STAGE
#undef PG8_LDA
#undef PG8_LDB
#undef PG8_MMA
#undef PG8_WAIT_V
#undef PG8_WAIT_L
#undef PG8_BAR
#undef PG8_SCHED
}
}
#define GAS __attribute__((address_space(1)))
#define LAS __attribute__((address_space(3)))
typedef unsigned short bf16;
typedef unsigned v4u __attribute__((ext_vector_type(4)));
typedef unsigned v2u __attribute__((ext_vector_type(2)));
typedef float f32x4 __attribute__((ext_vector_type(4)));
typedef float f32x2 __attribute__((ext_vector_type(2)));
typedef short bf16x8 __attribute__((ext_vector_type(8)));
typedef short s16x4 __attribute__((ext_vector_type(4)));

constexpr int T = 8192, D = 2048, NQW = 1024, NKVW = 256, MW = 1024, INW = 5640, NIN = 5632;
constexpr int NEXP = 64, DE = 512;
constexpr int NWAVES = 8, NTHR = 512;
constexpr float EPS = 1e-6f;
constexpr int LDS_BYTES = 147456;
constexpr size_t MiB = 1u << 20;
constexpr size_t WS_CTL = 0, CTL_ZERO_BYTES = 64 * 1024;
constexpr size_t WS_MODP = 1 * MiB;
constexpr size_t WS_MODP0 = 13 * MiB;
constexpr size_t WS_MODF = 3 * MiB;
constexpr size_t WS_COS = 4 * MiB, WS_SIN = 5 * MiB;
constexpr size_t WS_GATES = 6 * MiB;
constexpr size_t WS_GA = 6 * MiB + 256 * 1024, WS_GB = WS_GA + 128 * 1024, WS_GM = WS_GB + 128 * 1024;
constexpr size_t WS_CS = WS_GM + 128 * 1024;
constexpr size_t WS_DEN = WS_CS + 64 * 1024;
constexpr size_t WS_ROUTE = 7 * MiB;
constexpr size_t WS_WCH = 12 * MiB;
constexpr size_t WS_ABC = 14 * MiB;
constexpr size_t WS_PAN = 11 * MiB;
constexpr size_t WS_HIST = 10 * MiB;
constexpr size_t WS_LISTS = 8 * MiB;
constexpr int LCAP = 8192;
constexpr size_t WS_WINT = 16 * MiB, WS_WOUTT = 38 * MiB, WS_HN = 48 * MiB;
constexpr size_t WS_QA = 80 * MiB, WS_KA = 96 * MiB, WS_VA = 100 * MiB, WS_MQ0 = 104 * MiB, WS_MK0 = 120 * MiB, WS_MV = 136 * MiB, WS_MO = 152 * MiB;
constexpr size_t WS_MQ = 168 * MiB, WS_MK = 184 * MiB, WS_NUM = 200 * MiB, WS_YMIX = 232 * MiB, WS_Y = 264 * MiB, WS_X1 = 328 * MiB;
constexpr size_t WS_XG = 80 * MiB;
constexpr size_t WS_HG = 208 * MiB;
constexpr size_t WS_YA = 392 * MiB;
constexpr size_t WS_W13T = 456 * MiB;
constexpr size_t WS_W2T = 712 * MiB;
constexpr size_t WS_END = 840 * MiB;
constexpr int CW_TMO = 0, CW_BAR = 4096, CW_CNT = 8192  ;

#define RLX_AGENT __ATOMIC_RELAXED, __HIP_MEMORY_SCOPE_AGENT
__device__ __forceinline__ float bf2f(unsigned v) { return __uint_as_float(v << 16); }
typedef float f32x2_t __attribute__((ext_vector_type(2))); typedef __bf16 bf16x2_t __attribute__((ext_vector_type(2)));
__device__ __forceinline__ unsigned pk2(float lo, float hi) { f32x2_t v = {lo, hi}; bf16x2_t b = __builtin_convertvector(v, bf16x2_t); return __builtin_bit_cast(unsigned, b); }
__device__ __forceinline__ v2u pk4(f32x4 v) { v2u r; r.x = pk2(v.x, v.y); r.y = pk2(v.z, v.w); return r; }
__device__ __forceinline__ float wave_sum(float v) {
#pragma unroll
    for (int o = 1; o < 64; o <<= 1) v += __shfl_xor(v, o);
    return v;
}
__device__ __forceinline__ float wave_max(float v) {
#pragma unroll
    for (int o = 1; o < 64; o <<= 1) v = fmaxf(v, __shfl_xor(v, o));
    return v;
}
__device__ __forceinline__ float siluf(float v) { return v / (1.f + __expf(-v)); }
__device__ __forceinline__ float sigmoidf_(float v) { return 1.f / (1.f + __expf(-v)); }
__device__ __forceinline__ bf16x8 cat8(s16x4 a, s16x4 b) { bf16x8 r; r[0] = a[0]; r[1] = a[1]; r[2] = a[2]; r[3] = a[3]; r[4] = b[0]; r[5] = b[1]; r[6] = b[2]; r[7] = b[3]; return r; }
__device__ __forceinline__ s16x4 tr16(const LAS unsigned char* p) { return __builtin_bit_cast(s16x4, __builtin_amdgcn_ds_read_tr16_b64_v4i16((LAS s16x4*)p)); }
__device__ __forceinline__ bf16x8 pack8(f32x4 a, f32x4 b) { v4u r; r.x = pk2(a.x, a.y); r.y = pk2(a.z, a.w); r.z = pk2(b.x, b.y); r.w = pk2(b.z, b.w); return __builtin_bit_cast(bf16x8, r); }
__device__ __forceinline__ float swap1(float x) { return __int_as_float(__builtin_amdgcn_update_dpp(0, __float_as_int(x), 0xB1, 0xF, 0xF, true)); }
#define MFMA16(a, b, c) __builtin_amdgcn_mfma_f32_16x16x32_bf16((a), (b), (c), 0, 0, 0)

__device__ const float ROPE_INV[32] = {1.000000000e+00f, 7.498942018e-01f, 5.623413324e-01f, 4.216965139e-01f, 3.162277639e-01f, 2.371373773e-01f, 1.778279394e-01f, 1.333521456e-01f, 1.000000015e-01f, 7.498942316e-02f, 5.623413250e-02f, 4.216964915e-02f, 3.162277490e-02f, 2.371373773e-02f, 1.778279431e-02f, 1.333521400e-02f, 9.999999776e-03f, 7.498942316e-03f, 5.623413250e-03f, 4.216964822e-03f, 3.162277630e-03f, 2.371373819e-03f, 1.778279431e-03f, 1.333521446e-03f, 1.000000047e-03f, 7.498941850e-04f, 5.623413017e-04f, 4.216965172e-04f, 3.162277571e-04f, 2.371373703e-04f, 1.778279402e-04f, 1.333521504e-04f};

struct Args { const float* in[22]; float* out; unsigned char* ws; int ph_lo, ph_hi; };
enum { I_X = 0, I_C, I_WADA, I_BADA, I_GPREMIX, I_GPOSTMIX, I_GPREFFN, I_GPOSTFFN, I_WIN, I_BGATES, I_CONVW, I_CONVB, I_SINKS, I_MNORM, I_WOUT, I_WGROUP, I_BGROUP, I_WEXPERT, I_BEXPERT, I_W1, I_W3, I_W2 };
#define XBLAS LAS
#define XB_TMO      128
#define XB_XCNT(j)  (256  + 64 * (j))
#define XB_XSUB(j)  (1280 + 64 * (j))
#define XB_XGEN(j)  (2304 + 64 * (j))
#define XB_TOP      3328
#define XB_TOPGEN   3392
#define XCD_BAR_WORDS 3456
#define XB_SPIN_CAP (1u << 18)

__device__ __forceinline__ unsigned xb_ld(unsigned* p)              { return __hip_atomic_load(p, __ATOMIC_RELAXED, __HIP_MEMORY_SCOPE_AGENT); }
__device__ __forceinline__ unsigned xb_add(unsigned* p, unsigned v) { return __hip_atomic_fetch_add(p, v, __ATOMIC_RELAXED, __HIP_MEMORY_SCOPE_AGENT); }
__device__ __forceinline__ unsigned xb_xcc_id() { return (unsigned)__builtin_amdgcn_s_getreg((3 << 11) | 20) & 0xFu; }
#define XB_SPIN(cond, bar) do { unsigned _sp = 0; while (cond) { __builtin_amdgcn_s_sleep(1); \
    if ((++_sp & 255u) == 0u) { if (xb_ld(&(bar)[XB_TMO])) break; if (_sp > XB_SPIN_CAP) { atomicAdd(&(bar)[XB_TMO], 1u); break; } } } } while (0)

struct XcdBarrier {
    unsigned* bar; unsigned x;
    volatile LAS unsigned* st;
};

__device__ __forceinline__ XcdBarrier xcd_barrier_post(unsigned* bar, volatile LAS unsigned* st) {
    XcdBarrier b; b.bar = bar; b.x = xb_xcc_id(); b.st = st;
    if (threadIdx.x == 0) (void)xb_add(&bar[XB_XCNT(b.x)], 1u);
    return b;
}
__device__ __forceinline__ void xcd_barrier_complete(unsigned* bar, unsigned x, unsigned& nloc, unsigned& nx) {
    const unsigned G = gridDim.x * gridDim.y * gridDim.z;
    unsigned sum, cnt, mine, sp = 0u;
    for (;;) {
        sum = 0u; cnt = 0u; mine = 0u;
#pragma unroll
        for (unsigned j = 0; j < 16; ++j) { const unsigned c = xb_ld(&bar[XB_XCNT(j)]); sum += c; cnt += (c > 0u) ? 1u : 0u; mine = (j == x) ? c : mine; }
        if (sum == G) break;
        __builtin_amdgcn_s_sleep(1);
        if ((++sp & 255u) == 0u) { if (xb_ld(&bar[XB_TMO])) break; if (sp > XB_SPIN_CAP) { atomicAdd(&bar[XB_TMO], 1u); break; } }
    }
    nloc = mine > 0u ? mine : 1u; nx = cnt > 0u ? cnt : 1u;
}

__device__ __forceinline__ void xcd_barrier(const XcdBarrier& b) {
    asm volatile("s_waitcnt vmcnt(0)" ::: "memory");
    __syncthreads();
    if (threadIdx.x == 0) {
        unsigned* bar = b.bar;
        __builtin_amdgcn_s_waitcnt(0);
        unsigned nloc = b.st[0], nx = b.st[1];
        if (nloc == 0u) { xcd_barrier_complete(bar, b.x, nloc, nx); b.st[0] = nloc; b.st[1] = nx; }
        const unsigned old = xb_add(&bar[XB_XSUB(b.x)], 1u);
        const unsigned gen = old / nloc;
        if (old + 1u == (gen + 1u) * nloc) {
            __builtin_amdgcn_fence(__ATOMIC_RELEASE, "agent");
            asm volatile("s_waitcnt vmcnt(0)" ::: "memory");
            const unsigned og = xb_add(&bar[XB_TOP], 1u);
            const unsigned tg = og / nx;
            if (og + 1u == (tg + 1u) * nx) xb_add(&bar[XB_TOPGEN], 1u);
            else XB_SPIN(xb_ld(&bar[XB_TOPGEN]) == tg, bar);
            __builtin_amdgcn_fence(__ATOMIC_ACQUIRE, "agent");
            xb_add(&bar[XB_XGEN(b.x)], 1u);
            asm volatile("s_waitcnt vmcnt(0)" ::: "memory");
        } else {
            XB_SPIN(xb_ld(&bar[XB_XGEN(b.x)]) == gen, bar);
            __builtin_amdgcn_fence(__ATOMIC_ACQUIRE, "agent");
            asm volatile("s_waitcnt vmcnt(0)" ::: "memory");
        }
    }
    __syncthreads();
}
__device__ __forceinline__ int swap45(int p) { return (p & ~48) | ((p & 16) << 1) | ((p & 32) >> 1); }
template <int MODE>
__device__ __forceinline__ void transpose_item(const float* W, int ldw, int K, bf16* WT, int dbase, LAS float* scr_, int kb, int nb, int lane) {
    LAS unsigned char* scr = (LAS unsigned char*)scr_;
    const int k0 = 64 * kb, n0 = 64 * nb, kq = lane >> 4, nq = lane & 15;
    f32x4 v[16];
    const float* wp = W + (size_t)(k0 + 16 * kq) * ldw + n0 + 4 * nq;
#pragma unroll
    for (int j = 0; j < 16; ++j) v[j] = *(const f32x4*)(wp + (size_t)j * ldw);
#pragma unroll
    for (int c = 0; c < 4; ++c) { v4u lo, hi;
        lo.x = pk2(v[0][c], v[1][c]); lo.y = pk2(v[2][c], v[3][c]); lo.z = pk2(v[4][c], v[5][c]); lo.w = pk2(v[6][c], v[7][c]);
        hi.x = pk2(v[8][c], v[9][c]); hi.y = pk2(v[10][c], v[11][c]); hi.z = pk2(v[12][c], v[13][c]); hi.w = pk2(v[14][c], v[15][c]);
        const int n = 4 * nq + c, sw = nq & 7;
        *(LAS v4u*)(scr + n * 128 + 16 * ((2 * kq) ^ sw)) = lo; *(LAS v4u*)(scr + n * 128 + 16 * ((2 * kq + 1) ^ sw)) = hi; }
    asm volatile("s_waitcnt lgkmcnt(0)" ::: "memory");
    const int ch = lane & 7;
#pragma unroll
    for (int jj = 0; jj < 8; ++jj) { const int n = (lane >> 3) + 8 * jj;
        const v4u o = *(const LAS v4u*)(scr + n * 128 + 16 * (ch ^ ((n >> 2) & 7)));
        const int ns = n0 + n; int dr;
        if (MODE == 0) dr = ns; else dr = (ns < 1280) ? ((ns & ~63) | swap45(ns & 63)) : ns;
        *(v4u*)(WT + (size_t)(dbase + dr) * K + k0 + 8 * ch) = o; }
    asm volatile("s_waitcnt lgkmcnt(0)" ::: "memory");
}
template <int PART> __device__ __forceinline__ void phase0(const Args& a, LAS unsigned char* lds, int tid, int lane, int wave, int gw, int NGW) {
    unsigned char* ws = a.ws;
    LAS float* scr = (LAS float*)(lds + wave * 16384);
    {
        const float* c = a.in[I_C]; const float* W = a.in[I_WADA]; float* MODP = (float*)(ws + WS_MODP);
        constexpr int NB0 = 16, NBN = PART == 0 ? NB0 : 48 - NB0;
        if (PART == 0) {
            float* MODP0 = (float*)(ws + WS_MODP0);
            for (int wi = blockIdx.x; wi < 256; wi += gridDim.x) { const int kg = wi >> 6, cb = wi & 63, kb = 8 * kg + wave, r4 = lane >> 4, c4 = lane & 15;
                const float sv = siluf(c[64 * kb + lane]);
                f32x4 acc = {0.f, 0.f, 0.f, 0.f}, wv[16];
                const float* wp = W + (size_t)(64 * kb + r4) * 12288 + 64 * cb + 4 * c4;
#pragma unroll
                for (int i = 0; i < 16; ++i) wv[i] = *(const f32x4*)(wp + (size_t)(4 * i) * 12288);
#pragma unroll
                for (int i = 0; i < 16; ++i) acc += __shfl(sv, r4 + 4 * i) * wv[i];
#pragma unroll
                for (int q = 0; q < 4; ++q) { acc[q] += __shfl_xor(acc[q], 16); acc[q] += __shfl_xor(acc[q], 32); }
                if (lane < 16) *(LAS f32x4*)(scr + 4 * lane) = acc;
                __syncthreads();
                if (tid < 64) { float s = 0.f;
#pragma unroll
                    for (int w = 0; w < 8; ++w) s += *(const LAS float*)(lds + w * 16384 + 4 * tid);
                    MODP0[(size_t)(64 * cb + tid) * 4 + kg] = s; }
                __syncthreads(); }
        } else
        for (int it = gw; it < 32 * NBN; it += NGW) {
            const int kb = it / NBN, nb = it % NBN + (PART == 0 ? 0 : NB0);
            const float sv = siluf(c[64 * kb + lane]);
            f32x4 acc = {0.f, 0.f, 0.f, 0.f};
            const float* wp = W + (size_t)(64 * kb) * 12288 + 256 * nb + 4 * lane;
#pragma unroll 8
            for (int kk = 0; kk < 64; ++kk) { const float s = __shfl(sv, kk); const f32x4 w = *(const f32x4*)(wp + (size_t)kk * 12288); acc += s * w; }
            { float* mp = MODP + (size_t)(256 * nb + 4 * lane) * 32 + kb;
              mp[0] = acc.x; mp[32] = acc.y; mp[64] = acc.z; mp[96] = acc.w; }
        }
    }
    if (PART == 0) { const float* W = a.in[I_WIN]; float* PAN = (float*)(ws + WS_PAN);
        for (int idx = blockIdx.x * NTHR + tid; idx < 2048 * 8; idx += gridDim.x * NTHR) { const int k = idx >> 3, o = idx & 7; PAN[o * 2048 + k] = W[(size_t)k * INW + NIN + o]; } }
    if (PART == 0) {
        float* COS = (float*)(ws + WS_COS); float* SIN = (float*)(ws + WS_SIN);
        for (int idx = blockIdx.x * NTHR + tid; idx < T * 32; idx += gridDim.x * NTHR) {
            const int t = idx >> 5, i = idx & 31;
            const float angf = (float)t * ROPE_INV[i];
            const double x = (double)angf;
            const double q = __builtin_rint(x * 0.63661977236758134308);
            const double r = (x - q * 1.57079632679489655800) - q * 6.12323399573676603587e-17;
            const double r2 = r * r;
            const double sn = r * (1.0 + r2 * (-1.0 / 6 + r2 * (1.0 / 120 + r2 * (-1.0 / 5040 + r2 * (1.0 / 362880 + r2 * (-1.0 / 39916800 + r2 * (1.0 / 6227020800.0)))))));
            const double cs = 1.0 + r2 * (-0.5 + r2 * (1.0 / 24 + r2 * (-1.0 / 720 + r2 * (1.0 / 40320 + r2 * (-1.0 / 3628800 + r2 * (1.0 / 479001600 + r2 * (-1.0 / 87178291200.0)))))));
            const int qi = ((int)q) & 3;
            const double cv = (qi == 0) ? cs : (qi == 1) ? -sn : (qi == 2) ? -cs : sn;
            const double sv = (qi == 0) ? sn : (qi == 1) ? cs : (qi == 2) ? -sn : -cs;
            COS[idx] = (float)cv; SIN[idx] = (float)sv;
        }
    }
    if (PART == 1) { const float* wexp = a.in[I_WEXPERT]; const float* wgrp = a.in[I_WGROUP]; v4u* WCF = (v4u*)(ws + WS_WCH);
        for (int idx = gw * 64 + lane; idx < 80 * 256; idx += NGW * 64) { const int n = idx % 80, kk = idx / 80, k0 = kk * 8; float v[8];
#pragma unroll
            for (int j = 0; j < 8; ++j) v[j] = (n < 64) ? wexp[(size_t)(k0 + j) * 64 + n] : ((n < 72) ? wgrp[(size_t)(k0 + j) * 8 + (n - 64)] : 0.f);
            v4u hi, lo; unsigned* hp = (unsigned*)&hi; unsigned* lp = (unsigned*)&lo;
#pragma unroll
            for (int j = 0; j < 4; ++j) { const unsigned h = pk2(v[2 * j], v[2 * j + 1]); hp[j] = h; lp[j] = pk2(v[2 * j] - bf2f(h & 0xffffu), v[2 * j + 1] - bf2f(h >> 16)); }
            const int w_ = kk >> 5, blk = (kk >> 2) & 7, g = kk & 3, nt = n >> 4, i = n & 15; const size_t o = ((size_t)((w_ * 8 + blk) * 5 + nt) * 2) * 64 + 16 * g + i;
            WCF[o] = hi; WCF[o + 64] = lo; } }
    {
        bf16* WINT = (bf16*)(ws + WS_WINT); bf16* WOUTT = (bf16*)(ws + WS_WOUTT);
        constexpr int N_IN = 32 * 88, N_OUT = 32 * 32, N_IT = PART == 0 ? N_IN : N_OUT;
        const int nwg = NGW / NWAVES, bw = gw / NWAVES, per = (N_IT + nwg - 1) / nwg, lo = bw * per, hi = (lo + per < N_IT) ? lo + per : N_IT;
        for (int r = lo + wave; r < hi; r += NWAVES) {
            if (PART == 0) transpose_item<1>(a.in[I_WIN], INW, D, WINT, 0, scr, r / 88, r % 88, lane);
            else transpose_item<0>(a.in[I_WOUT], D, D, WOUTT, 0, scr, r / 32, r % 32, lane);
        }
    }
}

__device__ __forceinline__ float mod_sum(const float* MODP, const float* b_ada, int n) {
    const f32x4* p = (const f32x4*)(MODP + (size_t)n * 32); f32x4 v[8];
#pragma unroll
    for (int q = 0; q < 8; ++q) v[q] = p[q];
    float s = b_ada[n];
#pragma unroll
    for (int q = 0; q < 8; ++q) { s += v[q].x; s += v[q].y; s += v[q].z; s += v[q].w; }
    return s; }

__device__ __forceinline__ void phase1(const Args& a, LAS unsigned char* lds, int tid, int lane, int wave) {
    unsigned char* ws = a.ws;
    const float* PAN = (const float*)(ws + WS_PAN);
    LAS float* lmod = (LAS float*)lds;
    LAS float* panel = (LAS float*)(lds + 16384);
    const float* x = a.in[I_X]; const float* g = a.in[I_GPREMIX]; bf16* HN = (bf16*)(ws + WS_HN); float* GATES = (float*)(ws + WS_GATES); const float* bg = a.in[I_BGATES];
    const int gw = blockIdx.x * NWAVES + wave, NGW = gridDim.x * NWAVES;
    f32x4 va[8], vb[8], gvv[8];
#pragma unroll
    for (int j = 0; j < 8; ++j) gvv[j] = *(const f32x4*)(g + 4 * lane + 256 * j);
#define P1_LOAD(v_, t_) do { const f32x4* xr_ = (const f32x4*)(x + (size_t)(t_) * D) + lane; _Pragma("unroll") for (int j_ = 0; j_ < 8; ++j_) v_[j_] = xr_[64 * j_]; } while (0)
    int t = gw;
    if (t < T) P1_LOAD(va, t);
    {
        const float* bada = a.in[I_BADA]; const f32x4* MODP0 = (const f32x4*)(ws + WS_MODP0); f32x4 pv_[8];
#pragma unroll
        for (int q = 0; q < 8; ++q) pv_[q] = MODP0[tid + q * NTHR];
#pragma unroll
        for (int q = 0; q < 8; ++q) { const int n = tid + q * NTHR; lmod[n] = bada[n] + ((pv_[q].x + pv_[q].y) + (pv_[q].z + pv_[q].w)); }
    }
    for (int idx = tid; idx < 2048 * 8 / 4; idx += NTHR) *(LAS f32x4*)(panel + 4 * idx) = *(const f32x4*)(PAN + 4 * idx);
    __syncthreads();
#define P1_ROW(v_, t_) do { float ss_ = 0.f; \
        _Pragma("unroll") for (int j_ = 0; j_ < 8; ++j_) ss_ += (v_[j_].x * v_[j_].x + v_[j_].y * v_[j_].y) + (v_[j_].z * v_[j_].z + v_[j_].w * v_[j_].w); \
        ss_ = wave_sum(ss_); const float rstd_ = 1.0f / sqrtf(ss_ * (1.0f / D) + EPS); \
        float gp_[8] = {0.f, 0.f, 0.f, 0.f, 0.f, 0.f, 0.f, 0.f}; \
        _Pragma("unroll") for (int j_ = 0; j_ < 8; ++j_) { const int k_ = 4 * lane + 256 * j_; \
            const f32x4 gv_ = gvv[j_], sh_ = *(const LAS f32x4*)(lmod + k_), sc_ = *(const LAS f32x4*)(lmod + 2048 + k_); \
            f32x4 h_ = (v_[j_] * rstd_) * gv_; h_ = h_ * (sc_ + 1.0f) + sh_; \
            *(v2u*)(HN + (size_t)(t_) * D + k_) = pk4(h_); \
            _Pragma("unroll") for (int o_ = 0; o_ < 8; ++o_) { const f32x4 w_ = *(const LAS f32x4*)(panel + o_ * 2048 + k_); gp_[o_] += (h_.x * w_.x + h_.y * w_.y) + (h_.z * w_.z + h_.w * w_.w); } \
            __builtin_amdgcn_sched_barrier(0); } \
        _Pragma("unroll") for (int o_ = 0; o_ < 8; ++o_) gp_[o_] = wave_sum(gp_[o_]); \
        if (lane == 0) { _Pragma("unroll") for (int o_ = 0; o_ < 8; ++o_) GATES[(size_t)(t_) * 8 + o_] = gp_[o_] + bg[o_]; } } while (0)
    for (; t < T; t += 2 * NGW) {
        const int t2 = t + NGW, t3 = t + 2 * NGW;
        if (t2 < T) P1_LOAD(vb, t2);
        P1_ROW(va, t);
        if (t2 < T) { if (t3 < T) P1_LOAD(va, t3); P1_ROW(vb, t2); }
    }
#undef P1_LOAD
#undef P1_ROW
}

struct EpiIn {
    static constexpr bool PERM = false, AFTER_DRAIN = false;
    bf16 *Qa, *Ka, *Va, *MQ0, *MK0, *MV, *MO; const float *COS, *SIN;
    __device__ __forceinline__ void operator()(const pg8::f32x4 (&acc)[2][2][4][2], const pg8::Unit& u, int wr, int wc, int fr, int fq) const {
        const int pn = u.pn;
        if (pn < 5) {
            const int L0 = 16 * (wc & 1) + 4 * fq;
#pragma unroll
            for (int ai = 0; ai < 2; ++ai)
#pragma unroll
                for (int m = 0; m < 4; ++m) {
                    const int row = u.pm * 256 + ai * 128 + wr * 64 + m * 16 + fr;
                    const f32x4 c = *(const f32x4*)(COS + (size_t)row * 32 + L0), s = *(const f32x4*)(SIN + (size_t)row * 32 + L0);
#pragma unroll
                    for (int bj = 0; bj < 2; ++bj) {
                        const int hh = 2 * bj + (wc >> 1);
                        const f32x4 t1 = acc[ai][bj][m][0], t2 = acc[ai][bj][m][1];
                        f32x4 o1 = t1 * c - t2 * s, o2 = t2 * c + t1 * s;
                        bf16* dst;
                        if (pn < 4) { o1 = o1 * 0.125f; o2 = o2 * 0.125f; dst = Qa + (size_t)row * NQW + (pn * 4 + hh) * 64; }
                        else dst = Ka + (size_t)row * NKVW + hh * 64;
                        *(v2u*)(dst + L0) = pk4(o1); *(v2u*)(dst + 32 + L0) = pk4(o2);
                    }
                }
        } else {
            bf16* base; int ld, cb;
            if (pn == 5) { base = Va; ld = NKVW; cb = 0; }
            else if (pn < 10) { base = MQ0; ld = MW; cb = (pn - 6) * 256; }
            else if (pn < 14) { base = MK0; ld = MW; cb = (pn - 10) * 256; }
            else if (pn < 18) { base = MV; ld = MW; cb = (pn - 14) * 256; }
            else { base = MO; ld = MW; cb = (pn - 18) * 256; }
#pragma unroll
            for (int ai = 0; ai < 2; ++ai)
#pragma unroll
                for (int m = 0; m < 4; ++m) {
                    const int row = u.pm * 256 + ai * 128 + wr * 64 + m * 16 + fr;
                    bf16* rp = base + (size_t)row * ld + cb + 32 * wc + 4 * fq;
#pragma unroll
                    for (int bj = 0; bj < 2; ++bj)
#pragma unroll
                        for (int n = 0; n < 2; ++n) *(v2u*)(rp + 128 * bj + 16 * n) = pk4(acc[ai][bj][m][n]);
                }
        }
    }
};

__device__ __forceinline__ void attn_phase(const Args& a, LAS unsigned char* lds, int tid, int lane, int wave) {
    unsigned char* ws = a.ws;
    const bf16* Qa = (const bf16*)(ws + WS_QA); const bf16* Ka = (const bf16*)(ws + WS_KA); const bf16* Va = (const bf16*)(ws + WS_VA); bf16* YMIX = (bf16*)(ws + WS_YMIX);
    LAS unsigned char* Kimg = lds; LAS unsigned char* Vimg = lds + 192 * 144;
    const int g = lane >> 4, i = lane & 15, q4 = (lane >> 2) & 3, p4 = lane & 3;
    const int G = gridDim.x;
    v4u kvr[3], vvr[3]; bf16x8 qn[2][2];
#define ATT_LOAD(it_) do { const int qb_ = (it_) >> 2, kvh_ = (it_) & 3, kb_ = qb_ * 64 - 128; \
        _Pragma("unroll") for (int u_ = 0; u_ < 3; ++u_) { const int idx_ = tid + u_ * NTHR, r_ = idx_ >> 3, ch_ = idx_ & 7, t_ = kb_ + r_; kvr[u_] = (v4u){0u, 0u, 0u, 0u}; vvr[u_] = (v4u){0u, 0u, 0u, 0u}; \
            if (t_ >= 0) { kvr[u_] = *(const v4u*)(Ka + (size_t)t_ * NKVW + kvh_ * 64 + ch_ * 8); vvr[u_] = *(const v4u*)(Va + (size_t)t_ * NKVW + kvh_ * 64 + ch_ * 8); } } \
        { const int head_ = kvh_ * 4 + (wave >> 1), qw_ = qb_ * 64 + 32 * (wave & 1); \
          _Pragma("unroll") for (int qt_ = 0; qt_ < 2; ++qt_) _Pragma("unroll") for (int ks_ = 0; ks_ < 2; ++ks_) qn[qt_][ks_] = *(const bf16x8*)(Qa + (size_t)(qw_ + 16 * qt_ + i) * NQW + head_ * 64 + 32 * ks_ + 8 * g); } } while (0)
    int it = blockIdx.x;
    if (it < 128 * 4) ATT_LOAD(it);
    for (; it < 128 * 4; it += G) {
        const int qb = it >> 2, kvh = it & 3;
        const int q0 = qb * 64, kbase = q0 - 128;
#pragma unroll
        for (int u = 0; u < 3; ++u) { const int idx = tid + u * NTHR, r = idx >> 3, ch = idx & 7; *(LAS v4u*)(Kimg + r * 144 + ch * 16) = kvr[u]; *(LAS v4u*)(Vimg + r * 144 + ch * 16) = vvr[u]; }
        bf16x8 qf[2][2];
#pragma unroll
        for (int qt = 0; qt < 2; ++qt)
#pragma unroll
            for (int ks = 0; ks < 2; ++ks) qf[qt][ks] = qn[qt][ks];
        __syncthreads();
        if (it + G < 128 * 4) ATT_LOAD(it + G);
        const int head = kvh * 4 + (wave >> 1), qw0 = q0 + 32 * (wave & 1);
        f32x4 sacc[12][2];
#pragma unroll
        for (int kt = 0; kt < 12; ++kt) { sacc[kt][0] = (f32x4){0.f, 0.f, 0.f, 0.f}; sacc[kt][1] = (f32x4){0.f, 0.f, 0.f, 0.f}; }
#pragma unroll
        for (int kt = 0; kt < 12; ++kt)
#pragma unroll
            for (int ks = 0; ks < 2; ++ks) { const bf16x8 kf = *(const LAS bf16x8*)(Kimg + (16 * kt + i) * 144 + (32 * ks + 8 * g) * 2);
                sacc[kt][0] = MFMA16(kf, qf[0][ks], sacc[kt][0]); sacc[kt][1] = MFMA16(kf, qf[1][ks], sacc[kt][1]); }
        const float sink = a.in[I_SINKS][head];
        float linv[2];
#pragma unroll
        for (int qt = 0; qt < 2; ++qt) {
            const int qp = qw0 + 16 * qt + i;
            float mx = sink;
#pragma unroll
            for (int kt = 0; kt < 12; ++kt)
#pragma unroll
                for (int r = 0; r < 4; ++r) { const int kp = kbase + 16 * kt + 4 * g + r; const bool valid = (kp >= 0) && (kp <= qp) && (qp - kp < 128);
                    const float s = valid ? sacc[kt][qt][r] : -INFINITY; sacc[kt][qt][r] = s; mx = fmaxf(mx, s); }
            mx = fmaxf(mx, __shfl_xor(mx, 16)); mx = fmaxf(mx, __shfl_xor(mx, 32));
            float l = 0.f;
#pragma unroll
            for (int kt = 0; kt < 12; ++kt)
#pragma unroll
                for (int r = 0; r < 4; ++r) { const float p = __expf(sacc[kt][qt][r] - mx); sacc[kt][qt][r] = p; l += p; }
            l += __shfl_xor(l, 16); l += __shfl_xor(l, 32);
            l += __expf(sink - mx);
            linv[qt] = 1.0f / l;
        }
        f32x4 oacc[4][2];
#pragma unroll
        for (int dt = 0; dt < 4; ++dt) { oacc[dt][0] = (f32x4){0.f, 0.f, 0.f, 0.f}; oacc[dt][1] = (f32x4){0.f, 0.f, 0.f, 0.f}; }
#pragma unroll
        for (int u = 0; u < 6; ++u) {
            const bf16x8 pf0 = pack8(sacc[2 * u][0], sacc[2 * u + 1][0]), pf1 = pack8(sacc[2 * u][1], sacc[2 * u + 1][1]);
#pragma unroll
            for (int dt = 0; dt < 4; ++dt) {
                const s16x4 a1 = tr16(Vimg + (32 * u + 4 * g + q4) * 144 + (16 * dt + 4 * p4) * 2);
                const s16x4 a2 = tr16(Vimg + (32 * u + 16 + 4 * g + q4) * 144 + (16 * dt + 4 * p4) * 2);
                const bf16x8 vf = cat8(a1, a2);
                oacc[dt][0] = MFMA16(vf, pf0, oacc[dt][0]); oacc[dt][1] = MFMA16(vf, pf1, oacc[dt][1]);
            }
        }
#pragma unroll
        for (int qt = 0; qt < 2; ++qt)
#pragma unroll
            for (int dt = 0; dt < 4; ++dt) { const f32x4 o = oacc[dt][qt] * linv[qt];
                *(v2u*)(YMIX + (size_t)(qw0 + 16 * qt + i) * D + head * 64 + 16 * dt + 4 * g) = pk4(o); }
        __syncthreads();
    }
#undef ATT_LOAD
}

__device__ __forceinline__ void modf_phase(const Args& a, int tid, int bw, int nbw) {
    unsigned char* ws = a.ws;
    { const float* MODP = (const float*)(ws + WS_MODP); float* MODF = (float*)(ws + WS_MODF);
      for (int n = 5 * 2048 + bw * NTHR + tid; n < 12288; n += nbw * NTHR) MODF[n] = mod_sum(MODP, a.in[I_BADA], n);
      float* ABC = (float*)(ws + WS_ABC); const float* gpm = a.in[I_GPOSTMIX]; const float* gpf = a.in[I_GPREFFN];
      for (int n = bw * NTHR + tid; n < 2048; n += nbw * NTHR) { const float g1 = mod_sum(MODP, a.in[I_BADA], 2 * 2048 + n), s2 = mod_sum(MODP, a.in[I_BADA], 3 * 2048 + n), c2 = mod_sum(MODP, a.in[I_BADA], 4 * 2048 + n);
          ABC[n] = g1 * gpm[n]; ABC[2048 + n] = gpf[n] * (c2 + 1.0f); ABC[4096 + n] = s2; } }
}
__device__ __forceinline__ void conv_phase(const Args& a, int tid) {
    unsigned char* ws = a.ws;
    const bf16* MQ0 = (const bf16*)(ws + WS_MQ0); const bf16* MK0 = (const bf16*)(ws + WS_MK0); bf16* MQ = (bf16*)(ws + WS_MQ); bf16* MK = (bf16*)(ws + WS_MK);
    const float* cw = a.in[I_CONVW]; const float* cb = a.in[I_CONVB];
    for (int idx = blockIdx.x * NTHR + tid; idx < (T / 16) * 256; idx += gridDim.x * NTHR) {
        const int cc = (idx & 255) * 8, t0 = (idx >> 8) * 16;
        const bf16* src; bf16* dst; float scale; int c0;
        if (cc < 1024) { src = MQ0; dst = MQ; c0 = cc; scale = 1.0f; } else { src = MK0; dst = MK; c0 = cc - 1024; scale = 0.0625f; }
        v4u xs[19];
#pragma unroll
        for (int r = 0; r < 19; ++r) { const int tt = t0 - 3 + r; xs[r] = (v4u){0u, 0u, 0u, 0u}; if (tt >= 0) xs[r] = *(const v4u*)(src + (size_t)tt * MW + c0); }
        float w[4][8], bb[8];
#pragma unroll
        for (int j = 0; j < 4; ++j) { const f32x4 w0 = *(const f32x4*)(cw + j * 2048 + cc), w1 = *(const f32x4*)(cw + j * 2048 + cc + 4);
            w[j][0] = w0.x; w[j][1] = w0.y; w[j][2] = w0.z; w[j][3] = w0.w; w[j][4] = w1.x; w[j][5] = w1.y; w[j][6] = w1.z; w[j][7] = w1.w; }
        { const f32x4 b0 = *(const f32x4*)(cb + cc), b1 = *(const f32x4*)(cb + cc + 4); bb[0] = b0.x; bb[1] = b0.y; bb[2] = b0.z; bb[3] = b0.w; bb[4] = b1.x; bb[5] = b1.y; bb[6] = b1.z; bb[7] = b1.w; }
#pragma unroll
        for (int r = 0; r < 16; ++r) {
            float y[8];
#pragma unroll
            for (int e = 0; e < 8; ++e) y[e] = bb[e];
#pragma unroll
            for (int j = 0; j < 4; ++j) { const v4u xv = xs[r + j];
                y[0] += bf2f(xv.x & 0xffffu) * w[j][0]; y[1] += bf2f(xv.x >> 16) * w[j][1]; y[2] += bf2f(xv.y & 0xffffu) * w[j][2]; y[3] += bf2f(xv.y >> 16) * w[j][3];
                y[4] += bf2f(xv.z & 0xffffu) * w[j][4]; y[5] += bf2f(xv.z >> 16) * w[j][5]; y[6] += bf2f(xv.w & 0xffffu) * w[j][6]; y[7] += bf2f(xv.w >> 16) * w[j][7]; }
            v4u o; o.x = pk2(siluf(y[0]) * scale, siluf(y[1]) * scale); o.y = pk2(siluf(y[2]) * scale, siluf(y[3]) * scale); o.z = pk2(siluf(y[4]) * scale, siluf(y[5]) * scale); o.w = pk2(siluf(y[6]) * scale, siluf(y[7]) * scale);
            *(v4u*)(dst + (size_t)(t0 + r) * MW + c0) = o;
        }
    }
}

__device__ __forceinline__ void gate_prep(const Args& a, LAS unsigned char* lds, int hh, int tid, int lane, int wave) {
    unsigned char* ws = a.ws;
    const float* GATES = (const float*)(ws + WS_GATES);
    float* GA = (float*)(ws + WS_GA) + (size_t)hh * T; float* GB = (float*)(ws + WS_GB) + (size_t)hh * T; float* GM = (float*)(ws + WS_GM) + (size_t)hh * T;
    float* CSG = (float*)(ws + WS_CS) + hh * 128; float* CSM = (float*)(ws + WS_CS) + 512 + hh * 128;
    LAS float* Lb = (LAS float*)lds;
    LAS float* Lm = Lb + 128;
    LAS float* Ls = Lb + 256;
    float bb[16], be[16], pm[16];
#pragma unroll
    for (int cc = 0; cc < 16; ++cc) {
        const int c = wave + 8 * cc, t = c * 64 + lane;
        const float ig = GATES[(size_t)t * 8 + hh], fg = GATES[(size_t)t * 8 + 4 + hh];
        const float logf = fminf(fg, 0.f) - log1pf(__expf(-fabsf(fg)));
        float b = logf;
#pragma unroll
        for (int o = 1; o < 64; o <<= 1) { const float u = __shfl_up(b, o); if (lane >= o) b += u; }
        const float blast = __shfl(b, 63);
        const float beta = ig - b;
        float p = beta;
#pragma unroll
        for (int o = 1; o < 64; o <<= 1) { const float u = __shfl_up(p, o); if (lane >= o) p = fmaxf(p, u); }
        const float mloc = blast + __shfl(p, 63);
        if (lane == 0) { Lb[c] = blast; Lm[c] = mloc; }
        bb[cc] = b; be[cc] = beta; pm[cc] = p;
    }
    __syncthreads();
    if (tid == 0) { float m = 0.f; Ls[0] = 0.f; for (int c = 0; c < 128; ++c) { m = fmaxf(Lb[c] + m, Lm[c]); Ls[c + 1] = m; } }
    __syncthreads();
#pragma unroll
    for (int cc = 0; cc < 16; ++cc) {
        const int c = wave + 8 * cc, t = c * 64 + lane;
        const float m = Ls[c];
        const float mx = fmaxf(m, pm[cc]);
        GA[t] = -mx; GB[t] = be[cc]; GM[t] = bb[cc] + mx;
        if (lane == 0) { CSG[c] = Lb[c] - Ls[c + 1]; CSM[c] = m; }
    }
    __syncthreads();
}
constexpr int MC_Q = 0, MC_K = 33792, MC_V = 67584, MC_VW = 84992, MC_SW = 102400, MC_SC = 111616;
constexpr int NSEG = 21;
__device__ __forceinline__ int seg_begin(int g) { return g < 7 ? 7 * g : (g < 16 ? 49 + 6 * (g - 7) : 103 + 5 * (g - 16)); }
static_assert(103 + 5 * (21 - 16) == 128, "segments cover the 128 chunks");
constexpr size_t WS_LB = WS_Y;
template <bool SO, bool den_item>
__device__ __forceinline__ void mlstm_item(const Args& a, LAS unsigned char* lds, int hh, int eh, int seg, int tid, int lane, int wave) {
    unsigned char* ws = a.ws;
    const bf16* MQ = (const bf16*)(ws + WS_MQ); const bf16* MK = (const bf16*)(ws + WS_MK); const bf16* MV = (const bf16*)(ws + WS_MV);
    const float* GA = (const float*)(ws + WS_GA) + (size_t)hh * T; const float* GB = (const float*)(ws + WS_GB) + (size_t)hh * T;
    const float* CSG = (const float*)(ws + WS_CS) + hh * 128; const float* CSM = (const float*)(ws + WS_CS) + 512 + hh * 128;
    float* NUM = (float*)(ws + WS_NUM); float* DEN = (float*)(ws + WS_DEN) + (size_t)hh * T; float* LB = (float*)(ws + WS_LB);
    const int g = lane >> 4, i = lane & 15, q4 = (lane >> 2) & 3, p4 = lane & 3, et = wave;
    LAS unsigned char* Qi = lds + MC_Q; LAS unsigned char* Ki = lds + MC_K; LAS unsigned char* Vi = lds + MC_V; LAS unsigned char* Vw = lds + MC_VW; LAS unsigned char* Sw = lds + MC_SW;
    LAS float* SC = (LAS float*)(lds + MC_SC);
    const int c0 = seg_begin(seg), c1 = seg_begin(seg + 1);
    const unsigned vonum = (unsigned)((4 * g * MW + i) * 4);
    f32x4 Dst[16];
#pragma unroll
    for (int dt = 0; dt < 16; ++dt) Dst[dt] = (f32x4){0.f, 0.f, 0.f, 0.f};
    if (!SO) {
        const f32x4* Lp0 = (const f32x4*)(LB + ((((size_t)(hh * 3 + eh) * NSEG) * 8 + wave) * 16) * 256) + lane;
        f32x4 Lc[8], Ln[8];
        if (seg > 0) {
#pragma unroll
            for (int dt = 0; dt < 8; ++dt) Lc[dt] = Lp0[dt * 64];
        }
#pragma unroll 1
        for (int gp = 0; gp < seg; ++gp) {
            float la = 0.f;
            for (int c = seg_begin(gp); c < seg_begin(gp + 1); ++c) la += CSG[c] + CSM[c];
            const float A = __expf(la);
            const f32x4* Lg = Lp0 + (size_t)gp * (8 * 16 * 64);
#pragma unroll
            for (int dt = 0; dt < 8; ++dt) Ln[dt] = Lg[(8 + dt) * 64];
#pragma unroll
            for (int dt = 0; dt < 8; ++dt) Dst[dt] = Dst[dt] * A + Lc[dt];
            const f32x4* Lgn = Lp0 + (size_t)((gp + 1 < seg) ? gp + 1 : gp) * (8 * 16 * 64);
#pragma unroll
            for (int dt = 0; dt < 8; ++dt) Lc[dt] = Lgn[dt * 64];
#pragma unroll
            for (int dt = 0; dt < 8; ++dt) Dst[8 + dt] = Dst[8 + dt] * A + Ln[dt];
        }
    }
    v4u pq[4], pk[4], pv[2]; float pgb[2], pal = 0.f, pbe = 0.f;
    const char* MQu = (const char*)(MQ + hh * 256); const char* MKu = (const char*)(MK + hh * 256); const char* MVu = (const char*)(MV + hh * 256 + (den_item ? 0 : eh * 128));
    const unsigned voqk = (unsigned)(((tid >> 5) * MW + (tid & 31) * 8) * 2), vov = (unsigned)(((tid >> 4) * MW + (tid & 15) * 8) * 2), vogb = (unsigned)((tid >> 4) * 4);
#define MC_ISSUE(c_) do { const size_t tb_ = (size_t)(c_) * 64 * MW * 2; \
        _Pragma("unroll") for (int j_ = 0; j_ < 4; ++j_) pk[j_] = *(const v4u*)(MKu + (tb_ + (size_t)j_ * 16 * MW * 2) + voqk); \
        _Pragma("unroll") for (int j_ = 0; j_ < 2; ++j_) { pgb[j_] = *(const float*)((const char*)(GB + (c_) * 64 + j_ * 32) + vogb); \
            if (!den_item) pv[j_] = *(const v4u*)(MVu + (tb_ + (size_t)j_ * 32 * MW * 2) + vov); } \
        if (!SO && tid < 64) { pal = GA[(c_) * 64 + tid]; pbe = GB[(c_) * 64 + tid]; } } while (0)
#define MC_ISSUE_Q(c_) do { const size_t tb_ = (size_t)(c_) * 64 * MW * 2; \
        _Pragma("unroll") for (int j_ = 0; j_ < 4; ++j_) pq[j_] = *(const v4u*)(MQu + (tb_ + (size_t)j_ * 16 * MW * 2) + voqk); } while (0)
#define MC_STORE(c_) do { const float gam_ = CSG[(c_)], mp_ = CSM[(c_)]; \
        _Pragma("unroll") for (int j_ = 0; j_ < 4; ++j_) { const int idx_ = tid + j_ * NTHR, r_ = idx_ >> 5, ch_ = idx_ & 31; \
            if (!SO) *(LAS v4u*)(Qi + r_ * 528 + ch_ * 16) = pq[j_]; *(LAS v4u*)(Ki + r_ * 528 + ch_ * 16) = pk[j_]; } \
        _Pragma("unroll") for (int j_ = 0; j_ < 2; ++j_) { const int idx_ = tid + j_ * NTHR, r_ = idx_ >> 4, ch_ = idx_ & 15; \
            const float w_ = __expf(pgb[j_] + gam_); v4u vv_, vw_; \
            if (!den_item) { vv_ = pv[j_]; \
                vw_.x = pk2(bf2f(vv_.x & 0xffffu) * w_, bf2f(vv_.x >> 16) * w_); vw_.y = pk2(bf2f(vv_.y & 0xffffu) * w_, bf2f(vv_.y >> 16) * w_); \
                vw_.z = pk2(bf2f(vv_.z & 0xffffu) * w_, bf2f(vv_.z >> 16) * w_); vw_.w = pk2(bf2f(vv_.w & 0xffffu) * w_, bf2f(vv_.w >> 16) * w_); \
            } else { vv_ = (v4u){0u, 0u, 0u, 0u}; vw_ = (v4u){0u, 0u, 0u, 0u}; if (ch_ == 0) { vv_.x = 0x3f80u; vw_.x = pk2(w_, 0.f); } } \
            if (!SO) *(LAS v4u*)(Vi + r_ * 272 + ch_ * 16) = vv_; *(LAS v4u*)(Vw + r_ * 272 + ch_ * 16) = vw_; } \
        if (!SO && tid < 64) { SC[tid] = pal; SC[64 + tid] = pbe; SC[192 + tid] = __expf(pal + mp_); } } while (0)
    MC_ISSUE(c0); if (!SO) MC_ISSUE_Q(c0);
    MC_STORE(c0);
    __syncthreads();
    for (int c = c0; c < c1; ++c) {
        const int t0 = c * 64;
        const float a_old = __expf(CSG[c] + CSM[c]);
        if (c + 1 < c1) MC_ISSUE(c + 1);
        if (!SO) {
            f32x4 iacc[4];
            const int lt = wave >> 1;
#pragma unroll
            for (int sti = 0; sti < 2; ++sti) {
                const int st = 2 * (wave & 1) + sti;
                f32x4 acc = {0.f, 0.f, 0.f, 0.f};
#pragma unroll
                for (int ks = 0; ks < 8; ++ks) { const bf16x8 af = *(const LAS bf16x8*)(Qi + (16 * lt + i) * 528 + (32 * ks + 8 * g) * 2);
                    const bf16x8 bf = *(const LAS bf16x8*)(Ki + (16 * st + i) * 528 + (32 * ks + 8 * g) * 2); acc = MFMA16(af, bf, acc); }
                const int s = 16 * st + i; const float bs = SC[64 + s];
#pragma unroll
                for (int r = 0; r < 4; ++r) { const int l = 16 * lt + 4 * g + r; const float val = (s <= l) ? acc[r] * __expf(SC[l] + bs) : 0.f;
                    *(LAS unsigned short*)(Sw + l * 144 + s * 2) = (unsigned short)(pk2(val, 0.f) & 0xffffu); }
            }
#pragma unroll
            for (int lt2 = 0; lt2 < 4; ++lt2) iacc[lt2] = (f32x4){0.f, 0.f, 0.f, 0.f};
#pragma unroll
            for (int kb = 0; kb < 8; ++kb) {
                const bf16x8 bfr = pack8(Dst[2 * kb], Dst[2 * kb + 1]);
#pragma unroll
                for (int lt2 = 0; lt2 < 4; ++lt2) {
                    const v2u lo = *(const LAS v2u*)(Qi + (16 * lt2 + i) * 528 + (32 * kb + 4 * g) * 2), hi = *(const LAS v2u*)(Qi + (16 * lt2 + i) * 528 + (32 * kb + 16 + 4 * g) * 2);
                    v4u av; av.x = lo.x; av.y = lo.y; av.z = hi.x; av.w = hi.y;
                    iacc[lt2] = MFMA16(__builtin_bit_cast(bf16x8, av), bfr, iacc[lt2]);
                }
            }
#pragma unroll
            for (int lt2 = 0; lt2 < 4; ++lt2)
#pragma unroll
                for (int r = 0; r < 4; ++r) iacc[lt2][r] *= SC[192 + 16 * lt2 + 4 * g + r];
            __syncthreads();
#pragma unroll
            for (int ks2 = 0; ks2 < 2; ++ks2) {
                const bf16x8 bfr = cat8(tr16(Vi + (32 * ks2 + 8 * g + q4) * 272 + (16 * et + 4 * p4) * 2), tr16(Vi + (32 * ks2 + 8 * g + 4 + q4) * 272 + (16 * et + 4 * p4) * 2));
#pragma unroll
                for (int lt2 = 0; lt2 < 4; ++lt2) { const bf16x8 afr = *(const LAS bf16x8*)(Sw + (16 * lt2 + i) * 144 + (32 * ks2 + 8 * g) * 2); iacc[lt2] = MFMA16(afr, bfr, iacc[lt2]); }
            }
#pragma unroll
            for (int lt2 = 0; lt2 < 4; ++lt2)
#pragma unroll
                for (int r = 0; r < 4; ++r) { const float o = iacc[lt2][r];
                    if (!den_item) *(float*)((char*)(NUM + (size_t)(t0 + 16 * lt2 + r) * MW + hh * 256 + eh * 128 + 16 * et) + vonum) = o;
                    else if (wave == 0 && i == 0) DEN[t0 + 16 * lt2 + 4 * g + r] = o; }
        }
#pragma unroll
        for (int dt = 0; dt < 16; ++dt) Dst[dt] = Dst[dt] * a_old;
#pragma unroll
        for (int ks2 = 0; ks2 < 2; ++ks2) {
            const bf16x8 bfr = cat8(tr16(Vw + (32 * ks2 + 8 * g + q4) * 272 + (16 * et + 4 * p4) * 2), tr16(Vw + (32 * ks2 + 8 * g + 4 + q4) * 272 + (16 * et + 4 * p4) * 2));
#pragma unroll
            for (int dt = 0; dt < 16; ++dt) {
                const bf16x8 afr = cat8(tr16(Ki + (32 * ks2 + 8 * g + q4) * 528 + (16 * dt + 4 * p4) * 2), tr16(Ki + (32 * ks2 + 8 * g + 4 + q4) * 528 + (16 * dt + 4 * p4) * 2));
                Dst[dt] = MFMA16(afr, bfr, Dst[dt]);
            }
        }
        if (!SO && c + 1 < c1) MC_ISSUE_Q(c + 1);
        __syncthreads();
        if (c + 1 < c1) { MC_STORE(c + 1); }
        __syncthreads();
    }
#undef MC_ISSUE
#undef MC_ISSUE_Q
#undef MC_STORE
    if (SO) {
        f32x4* Lp = (f32x4*)(LB + ((((size_t)(hh * 3 + eh) * NSEG + seg) * 8 + wave) * 16) * 256) + lane;
#pragma unroll
        for (int dt = 0; dt < 16; ++dt) Lp[dt * 64] = Dst[dt];
    }
}

__device__ __forceinline__ void mlstm_norm_phase(const Args& a, int lane, int wave) {
    unsigned char* ws = a.ws;
    const float* NUM = (const float*)(ws + WS_NUM); const float* DEN = (const float*)(ws + WS_DEN); const float* GM = (const float*)(ws + WS_GM);
    const bf16* MO = (const bf16*)(ws + WS_MO); bf16* YMIX = (bf16*)(ws + WS_YMIX); const float* mn = a.in[I_MNORM];
    const int gw = blockIdx.x * NWAVES + wave, NGW = gridDim.x * NWAVES;
    f32x4 nva, nvb; float dena, denb, mta, mtb; v2u moa, mob;
#define P5_LOAD(nv_, den_, mt_, mo_, it_) do { const int t_ = (it_) >> 2, hh_ = (it_) & 3; nv_ = *(const f32x4*)(NUM + (size_t)t_ * MW + hh_ * 256 + 4 * lane); \
        den_ = DEN[(size_t)hh_ * T + t_]; mt_ = GM[(size_t)hh_ * T + t_]; mo_ = *(const v2u*)(MO + (size_t)t_ * MW + hh_ * 256 + 4 * lane); } while (0)
#define P5_ITEM(nv_, den_, mt_, mo_, it_) do { const int t_ = (it_) >> 2, hh_ = (it_) & 3; \
        const float dd_ = fmaxf(fabsf(den_), __expf(-mt_)); const f32x4 h_ = nv_ / dd_; \
        const float ss_ = wave_sum((h_.x * h_.x + h_.y * h_.y) + (h_.z * h_.z + h_.w * h_.w)); const float r_ = 1.0f / sqrtf(ss_ * (1.0f / 256.0f) + EPS); \
        const f32x4 mv_ = *(const f32x4*)(mn + hh_ * 256 + 4 * lane); f32x4 y_; \
        y_.x = sigmoidf_(bf2f(mo_.x & 0xffffu)) * (h_.x * r_ * mv_.x); y_.y = sigmoidf_(bf2f(mo_.x >> 16)) * (h_.y * r_ * mv_.y); \
        y_.z = sigmoidf_(bf2f(mo_.y & 0xffffu)) * (h_.z * r_ * mv_.z); y_.w = sigmoidf_(bf2f(mo_.y >> 16)) * (h_.w * r_ * mv_.w); \
        *(v2u*)(YMIX + (size_t)t_ * D + 1024 + hh_ * 256 + 4 * lane) = pk4(y_); } while (0)
    int it = gw; const int NIT = T * 4;
    if (it < NIT) P5_LOAD(nva, dena, mta, moa, it);
    for (; it < NIT; it += 2 * NGW) {
        const int i2 = it + NGW, i3 = it + 2 * NGW;
        if (i2 < NIT) P5_LOAD(nvb, denb, mtb, mob, i2);
        P5_ITEM(nva, dena, mta, moa, it);
        if (i2 < NIT) { if (i3 < NIT) P5_LOAD(nva, dena, mta, moa, i3); P5_ITEM(nvb, denb, mtb, mob, i2); }
    }
#undef P5_LOAD
#undef P5_ITEM
}

struct EpiY {
    static constexpr bool PERM = false, AFTER_DRAIN = false;
    float* Y;
    __device__ __forceinline__ void operator()(const pg8::f32x4 (&acc)[2][2][4][2], const pg8::Unit& u, int wr, int wc, int fr, int fq) const {
#pragma unroll
        for (int ai = 0; ai < 2; ++ai)
#pragma unroll
            for (int m = 0; m < 4; ++m) {
                const int row = u.pm * 256 + ai * 128 + wr * 64 + m * 16 + fr;
                float* rp = Y + (size_t)row * D + u.pn * 256 + 32 * wc + 4 * fq;
#pragma unroll
                for (int bj = 0; bj < 2; ++bj)
#pragma unroll
                    for (int n = 0; n < 2; ++n) *(f32x4*)(rp + 128 * bj + 16 * n) = acc[ai][bj][m][n];
            }
    }
};

__device__ __forceinline__ void phase7(const Args& a, LAS unsigned char* lds, int tid, int lane, int wave) {
    unsigned char* ws = a.ws;
    const float* Y = (const float*)(ws + WS_Y); float* X1 = (float*)(ws + WS_X1); bf16* HN = (bf16*)(ws + WS_HN);
    float* RW = (float*)(ws + WS_ROUTE + 65536);
    LAS int* rex = (LAS int*)(lds + 137216);
    int npass = 0;
    const float* x = a.in[I_X]; const float* bexp = a.in[I_BEXPERT]; const float* bgrp = a.in[I_BGROUP];
    constexpr int HP = 2052;
    LAS float* H2 = (LAS float*)lds;
    LAS float* LG = (LAS float*)(lds + 131584);
    const float* ABC = (const float*)(ws + WS_ABC);
    const __amdgpu_buffer_rsrc_t rW = __builtin_amdgcn_make_buffer_rsrc((void*)(ws + WS_WCH), (short)0, 80 * 2048 * 4, 0x00020000);
    for (int base = blockIdx.x * 16; base < T; base += gridDim.x * 16) {
        {
            const int r0 = 2 * wave, t0 = base + r0, t1 = t0 + 1;
            const f32x4* y0p = (const f32x4*)(Y + (size_t)t0 * D) + lane; const f32x4* y1p = (const f32x4*)(Y + (size_t)t1 * D) + lane;
            const f32x4* x0p = (const f32x4*)(x + (size_t)t0 * D) + lane; const f32x4* x1p = (const f32x4*)(x + (size_t)t1 * D) + lane;
            f32x4 v0[8], v1[8], xa[8], xb[8]; float ss0 = 0.f, ss1 = 0.f;
#pragma unroll
            for (int j = 0; j < 8; ++j) { v0[j] = y0p[64 * j]; v1[j] = y1p[64 * j]; }
#pragma unroll
            for (int j = 0; j < 8; ++j) { xa[j] = x0p[64 * j]; xb[j] = x1p[64 * j]; }
#pragma unroll
            for (int j = 0; j < 8; ++j) { ss0 += (v0[j].x * v0[j].x + v0[j].y * v0[j].y) + (v0[j].z * v0[j].z + v0[j].w * v0[j].w); ss1 += (v1[j].x * v1[j].x + v1[j].y * v1[j].y) + (v1[j].z * v1[j].z + v1[j].w * v1[j].w); }
            ss0 = wave_sum(ss0); ss1 = wave_sum(ss1);
            const float rs0 = 1.0f / sqrtf(ss0 * (1.0f / D) + EPS), rs1 = 1.0f / sqrtf(ss1 * (1.0f / D) + EPS);
            float q0 = 0.f, q1 = 0.f;
#pragma unroll
            for (int j = 0; j < 8; ++j) { const int k = 4 * lane + 256 * j; const f32x4 A = *(const f32x4*)(ABC + k);
                const f32x4 a0 = xa[j] + A * (v0[j] * rs0), a1 = xb[j] + A * (v1[j] * rs1);
                *(f32x4*)(X1 + (size_t)t0 * D + k) = a0; *(f32x4*)(X1 + (size_t)t1 * D + k) = a1; v0[j] = a0; v1[j] = a1;
                q0 += (a0.x * a0.x + a0.y * a0.y) + (a0.z * a0.z + a0.w * a0.w); q1 += (a1.x * a1.x + a1.y * a1.y) + (a1.z * a1.z + a1.w * a1.w); }
            q0 = wave_sum(q0); q1 = wave_sum(q1);
            const float rt0 = 1.0f / sqrtf(q0 * (1.0f / D) + EPS), rt1 = 1.0f / sqrtf(q1 * (1.0f / D) + EPS);
#pragma unroll
            for (int j = 0; j < 8; ++j) { const int k = 4 * lane + 256 * j; const f32x4 B = *(const f32x4*)(ABC + 2048 + k), C = *(const f32x4*)(ABC + 4096 + k);
                const f32x4 h0 = (v0[j] * rt0) * B + C, h1 = (v1[j] * rt1) * B + C;
                *(v2u*)(HN + (size_t)t0 * D + k) = pk4(h0); *(v2u*)(HN + (size_t)t1 * D + k) = pk4(h1);
                *(LAS f32x4*)(H2 + r0 * HP + k) = h0; *(LAS f32x4*)(H2 + (r0 + 1) * HP + k) = h1; }
        }
        __syncthreads();
        {
            const int g = lane >> 4, i = lane & 15;
            f32x4 lacc[5];
#pragma unroll
            for (int nt = 0; nt < 5; ++nt) lacc[nt] = (f32x4){0.f, 0.f, 0.f, 0.f};
            const LAS float* ap = H2 + i * HP + 256 * wave + 8 * g;
            const int wu = __builtin_amdgcn_readfirstlane(wave);
            v4u bq0[10], bq1[10];
#define LG_LOAD(set_, blk_) do { _Pragma("unroll") for (int f_ = 0; f_ < 10; ++f_) set_[f_] = __builtin_amdgcn_raw_buffer_load_b128(rW, lane * 16, ((wu * 8 + (blk_)) * 10 + f_) * 1024, 0); } while (0)
#define LG_STEP(set_, blk_) do { const f32x4 av0 = *(const LAS f32x4*)(ap + 32 * (blk_)), av1 = *(const LAS f32x4*)(ap + 32 * (blk_) + 4); \
                v4u ahi, alo; unsigned* hp = (unsigned*)&ahi; unsigned* lp = (unsigned*)&alo; \
                { const unsigned h = pk2(av0.x, av0.y); hp[0] = h; lp[0] = pk2(av0.x - bf2f(h & 0xffffu), av0.y - bf2f(h >> 16)); } \
                { const unsigned h = pk2(av0.z, av0.w); hp[1] = h; lp[1] = pk2(av0.z - bf2f(h & 0xffffu), av0.w - bf2f(h >> 16)); } \
                { const unsigned h = pk2(av1.x, av1.y); hp[2] = h; lp[2] = pk2(av1.x - bf2f(h & 0xffffu), av1.y - bf2f(h >> 16)); } \
                { const unsigned h = pk2(av1.z, av1.w); hp[3] = h; lp[3] = pk2(av1.z - bf2f(h & 0xffffu), av1.w - bf2f(h >> 16)); } \
                const bf16x8 fah = __builtin_bit_cast(bf16x8, ahi), fal = __builtin_bit_cast(bf16x8, alo); \
                _Pragma("unroll") for (int nt = 0; nt < 5; ++nt) { const bf16x8 fbh = __builtin_bit_cast(bf16x8, set_[2 * nt]), fbl = __builtin_bit_cast(bf16x8, set_[2 * nt + 1]); \
                    lacc[nt] = MFMA16(fal, fbh, lacc[nt]); lacc[nt] = MFMA16(fah, fbl, lacc[nt]); lacc[nt] = MFMA16(fah, fbh, lacc[nt]); } } while (0)
            LG_LOAD(bq0, 0);
#pragma unroll
            for (int b2 = 0; b2 < 4; ++b2) {
                LG_LOAD(bq1, 2 * b2 + 1); LG_STEP(bq0, 2 * b2); __builtin_amdgcn_sched_barrier(0);
                if (b2 < 3) LG_LOAD(bq0, 2 * b2 + 2);
                LG_STEP(bq1, 2 * b2 + 1); __builtin_amdgcn_sched_barrier(0);
            }
#undef LG_LOAD
#undef LG_STEP
            __syncthreads();
            LAS float* PART = H2 + wave * (16 * 80);
#pragma unroll
            for (int nt = 0; nt < 5; ++nt)
#pragma unroll
                for (int r = 0; r < 4; ++r) PART[(4 * g + r) * 80 + 16 * nt + i] = lacc[nt][r];
            __syncthreads();
            for (int idx = tid; idx < 16 * 80; idx += NTHR) { float s = 0.f;
#pragma unroll
                for (int w = 0; w < 8; ++w) s += H2[w * (16 * 80) + idx];
                const int n = idx % 80; s += (n < 64) ? bexp[n] : ((n < 72) ? bgrp[n - 64] : 0.f); LG[idx] = s; }
        }
        __syncthreads();
        if (tid < 16) {
            const int r = tid, t = base + r; const LAS float* lg = LG + r * 80;
            int gi = 0; float gm = lg[64];
#pragma unroll
            for (int j = 1; j < 8; ++j) { const float v = lg[64 + j]; if (v > gm) { gm = v; gi = j; } }
            float gs = 0.f;
#pragma unroll
            for (int j = 0; j < 8; ++j) gs += expf(lg[64 + j] - gm);
            const float gprob = 1.0f / gs;
            int i0 = 0; float v0 = lg[gi * 8];
#pragma unroll
            for (int j = 1; j < 8; ++j) { const float v = lg[gi * 8 + j]; if (v > v0) { v0 = v; i0 = j; } }
            int i1 = -1; float v1 = -INFINITY;
#pragma unroll
            for (int j = 0; j < 8; ++j) { const float v = lg[gi * 8 + j]; if (j != i0 && v > v1) { v1 = v; i1 = j; } }
            const float e1 = expf(v1 - v0); const float w0 = gprob / (1.0f + e1), w1 = gprob * e1 / (1.0f + e1);
            const int ex0 = gi * 8 + i0, ex1 = gi * 8 + i1;
            RW[2 * t] = w0; RW[2 * t + 1] = w1;
            rex[(npass * 16 + r) * 2] = ex0; rex[(npass * 16 + r) * 2 + 1] = ex1;
        }
        __syncthreads();
        ++npass;
    }
    {
        const int nasg = npass * 32;
        LAS int* lbase = rex + 2048;
        unsigned* CNT = (unsigned*)(ws + WS_CTL) + CW_CNT; int* LISTS = (int*)(ws + WS_LISTS);
        if (tid < NEXP) { int c = 0; for (int q = 0; q < nasg; ++q) c += (rex[q] == tid) ? 1 : 0;
            lbase[tid] = c ? (int)__hip_atomic_fetch_add(CNT + tid * 32, (unsigned)c, __ATOMIC_RELAXED, __HIP_MEMORY_SCOPE_AGENT) : 0; }
        __syncthreads();
        for (int j = tid; j < nasg; j += NTHR) { const int ej = rex[j]; int rk = 0; for (int q = 0; q < j; ++q) rk += (rex[q] == ej) ? 1 : 0;
            const int pass = j >> 5, r = (j >> 1) & 15, k = j & 1; const int t = ((int)blockIdx.x + pass * (int)gridDim.x) * 16 + r;
            LISTS[(size_t)ej * LCAP + lbase[ej] + rk] = 2 * t + k; }
        __syncthreads();
    }
}

constexpr int XG_RM = 256, XG_AP = 160, XG_BP = 272, XG_ABYTES = XG_RM * XG_AP, XG_BBYTES = 64 * XG_BP, XG_BUF = XG_ABYTES + XG_BBYTES;
static_assert(2 * XG_BUF <= 147456 - 2048, "expert GEMM LDS");
__device__ __forceinline__ int wave_iscan(int v, int lane) {
#pragma unroll
    for (int d = 1; d < 64; d <<= 1) { const int t = __shfl_up(v, d); if (lane >= d) v += t; }
    return v; }
__device__ __forceinline__ void expert_offsets(const unsigned* CNT, LAS int* cnts  , LAS int* offs  , LAS int* eptab  , int rm, int tid) {
    if (tid < NEXP) { const int lane = tid, c = (int)__hip_atomic_load(CNT + tid * 32, RLX_AGENT); const int np = (c + rm - 1) / rm;
        const int ic = wave_iscan(c, lane);
        cnts[lane] = c; offs[lane] = ic - c; if (lane == NEXP - 1) offs[NEXP] = ic;
        const int n2 = (np == 2) ? 2 : 0, n3 = (np >= 3) ? np : 0, n1 = (np == 1) ? 1 : 0;
        const int i2 = wave_iscan(n2, lane), i3 = wave_iscan(n3, lane), i1 = wave_iscan(n1, lane);
        const int t2 = __shfl(i2, 63), t3 = __shfl(i3, 63), t1 = __shfl(i1, 63);
        const int pos = (np == 2) ? (i2 - n2) : (np >= 3) ? (t2 + i3 - n3) : (t2 + t3 + i1 - n1);
        for (int p = 0; p < np; ++p) eptab[pos + p] = lane | (p << 8);
        if (lane == 0) eptab[191] = t2 + t3 + t1; }
    __syncthreads();
}
template <bool UP>
__device__ __forceinline__ void xgemm_unit(const Args& a, LAS unsigned char* lds, int e, int s, int cnt, int off_e, int rp, int tid, int lane, int wave) {
    unsigned char* ws = a.ws;
    constexpr int K = UP ? D : DE, NK = K / 64, LDB = UP ? DE : D;
    const int* LISTS = (const int*)(ws + WS_LISTS) + (size_t)e * LCAP; const float* RW = (const float*)(ws + WS_ROUTE + 65536);
    const bf16* Abase = UP ? (const bf16*)(ws + WS_HN) : (const bf16*)(ws + WS_HG);
    bf16* HG = (bf16*)(ws + WS_HG); bf16* YA = (bf16*)(ws + WS_YA);
    const bool loader = wave < 4;
    const int cw = wave & 3;
    {
        const int nrows = (cnt - rp < XG_RM) ? (cnt - rp) : XG_RM;
        if (loader) {
            const int tl = tid & 255;
            const int arow = tl >> 3, ach = tl & 7;
            const int n4 = UP ? (tl & 15) : (tl & 31), kr = UP ? ((tl >> 4) & 7) : (tl >> 5), bcol = UP ? (64 * ((wave >> 1) & 1) + 4 * n4) : 4 * n4;
            const float* Bu = UP ? ((((wave >> 1) & 1) ? a.in[I_W3] : a.in[I_W1]) + (size_t)e * D * DE) : (a.in[I_W2] + (size_t)e * DE * D);
            const __amdgpu_buffer_rsrc_t rB = __builtin_amdgcn_make_buffer_rsrc((void*)Bu, (short)0, K * LDB * 4, 0x00020000);
            const __amdgpu_buffer_rsrc_t rA = __builtin_amdgcn_make_buffer_rsrc((void*)Abase, (short)0, UP ? T * D * 2 : 2 * T * DE * 2, 0x00020000);
            const unsigned boff = (unsigned)(kr * LDB + 4 * n4 + (UP ? 64 : 128) * s) * 4u;
            const int bdst = XG_ABYTES + kr * XG_BP + bcol * 2;
            unsigned aoff[8];
#pragma unroll
            for (int j = 0; j < 8; ++j) { int rr = arow + 32 * j; rr = (rr < nrows) ? rr : (nrows - 1);
                if (UP) aoff[j] = ((unsigned)(LISTS[rp + rr] >> 1) * (unsigned)D + ach * 8) * 2u; else aoff[j] = ((unsigned)(off_e + rp + rr) * (unsigned)DE + ach * 8) * 2u; }
            f32x4 pb0[8], pb1[8], pb2[8]; v4u pa0[8], pa1[8], pa2[8];
            static_assert(NK % 3 == 2, "loader ring schedule");
#define XG_ISSUE_B(pb_, t_) do { _Pragma("unroll") for (int j_ = 0; j_ < 8; ++j_) pb_[j_] = __builtin_bit_cast(f32x4, __builtin_amdgcn_raw_buffer_load_b128(rB, boff, (64 * (t_) + 8 * j_) * LDB * 4, 0)); } while (0)
#define XG_ISSUE_A(pa_, t_) do { _Pragma("unroll") for (int j_ = 0; j_ < 8; ++j_) pa_[j_] = __builtin_amdgcn_raw_buffer_load_b128(rA, aoff[j_], 128 * (t_), 0); } while (0)
#define XG_STORE(pb_, pa_, bo_) do { _Pragma("unroll") for (int j_ = 0; j_ < 8; ++j_) *(LAS v2u*)(lds + (bo_) + bdst + 8 * j_ * XG_BP) = pk4(pb_[j_]); \
            _Pragma("unroll") for (int j_ = 0; j_ < 8; ++j_) *(LAS v4u*)(lds + (bo_) + (arow + 32 * j_) * XG_AP + ach * 16) = pa_[j_]; } while (0)
#define XG_STEP(t_, PBN, PAN, PBS, PAS) do { XG_ISSUE_A(PAN, (t_) + 2); { const int tb_ = ((t_) + 3 < NK) ? (t_) + 3 : NK - 1; XG_ISSUE_B(PBN, tb_); } \
                XG_STORE(PBS, PAS, (((t_) + 1) & 1) * XG_BUF); __syncthreads(); } while (0)
            XG_ISSUE_A(pa0, 0); XG_ISSUE_B(pb0, 0); XG_ISSUE_A(pa1, 1); XG_ISSUE_B(pb1, 1); XG_ISSUE_B(pb2, 2);
            XG_STORE(pb0, pa0, 0);
            __syncthreads();
#pragma unroll
            for (int t = 0; t + 3 <= NK - 2; t += 3) {
                XG_STEP(t, pb0, pa2, pb1, pa1);
                XG_STEP(t + 1, pb1, pa0, pb2, pa2);
                XG_STEP(t + 2, pb2, pa1, pb0, pa0);
            }
            XG_STORE(pb1, pa1, ((NK - 1) & 1) * XG_BUF); __syncthreads();
            __syncthreads();
#undef XG_ISSUE_A
#undef XG_ISSUE_B
#undef XG_STEP
#undef XG_STORE
        } else {
            const int g = lane >> 4, i = lane & 15, q4 = (lane >> 2) & 3, p4 = lane & 3;
            f32x4 acc[4][8];
#pragma unroll
            for (int mi = 0; mi < 4; ++mi)
#pragma unroll
                for (int nt = 0; nt < 8; ++nt) acc[mi][nt] = (f32x4){0.f, 0.f, 0.f, 0.f};
            LAS int* rinfo = (LAS int*)(lds + 2 * XG_BUF + 2048) + cw * 128;
            if (!UP) { const int row_ = 64 * cw + lane; int as_ = 0; float w_ = 0.f; if (row_ < nrows) { as_ = LISTS[rp + row_]; w_ = RW[as_]; } rinfo[2 * lane] = as_; rinfo[2 * lane + 1] = __float_as_int(w_); }
#define XG_LDA(dst_, bo_, ks_) do { _Pragma("unroll") for (int mi_ = 0; mi_ < 4; ++mi_) dst_[mi_] = *(const LAS bf16x8*)(lds + (bo_) + (16 * (4 * cw + mi_) + i) * XG_AP + (32 * (ks_) + 8 * g) * 2); } while (0)
#define XG_LDB(dst_, bo_, ks_, nh_) do { _Pragma("unroll") for (int nt_ = 0; nt_ < 4; ++nt_) dst_[nt_] = cat8(tr16(lds + (bo_) + XG_ABYTES + (32 * (ks_) + 8 * g + q4) * XG_BP + (16 * (4 * (nh_) + nt_) + 4 * p4) * 2), tr16(lds + (bo_) + XG_ABYTES + (32 * (ks_) + 8 * g + 4 + q4) * XG_BP + (16 * (4 * (nh_) + nt_) + 4 * p4) * 2)); } while (0)
#define XG_MM(a_, b_, nh_) do { _Pragma("unroll") for (int mi_ = 0; mi_ < 4; ++mi_) _Pragma("unroll") for (int nt_ = 0; nt_ < 4; ++nt_) acc[mi_][4 * (nh_) + nt_] = MFMA16(a_[mi_], b_[nt_], acc[mi_][4 * (nh_) + nt_]); } while (0)
#define XG_COMPUTE(bo_) do { bf16x8 fa0_[4], fb0_[4], fb1_[4]; \
                XG_LDA(fa0_, bo_, 0); XG_LDB(fb0_, bo_, 0, 0); __builtin_amdgcn_sched_barrier(0); \
                XG_LDB(fb1_, bo_, 0, 1); XG_MM(fa0_, fb0_, 0); __builtin_amdgcn_sched_barrier(0); \
                XG_LDB(fb0_, bo_, 1, 0); XG_MM(fa0_, fb1_, 1); __builtin_amdgcn_sched_barrier(0); \
                XG_LDA(fa0_, bo_, 1); XG_LDB(fb1_, bo_, 1, 1); XG_MM(fa0_, fb0_, 0); __builtin_amdgcn_sched_barrier(0); \
                XG_MM(fa0_, fb1_, 1); } while (0)
            __syncthreads();
#pragma unroll 1
            for (int t = 0; t < NK; t += 2) {
                XG_COMPUTE(0);
                __syncthreads();
                XG_COMPUTE(XG_BUF);
                __syncthreads();
            }
#undef XG_COMPUTE
#undef XG_LDA
#undef XG_LDB
#undef XG_MM
            {
                const bool odd = (i & 1) != 0;
                if (UP) {
                    LAS unsigned char* stg = lds + XG_BUF + cw * 9216;
#pragma unroll
                    for (int mi = 0; mi < 4; ++mi)
#pragma unroll
                        for (int r = 0; r < 4; ++r) { const int lrow = 16 * mi + 4 * g + r;
#pragma unroll
                            for (int q = 0; q < 2; ++q) { const float a0 = siluf(acc[mi][2 * q][r]) * acc[mi][2 * q + 4][r], a1 = siluf(acc[mi][2 * q + 1][r]) * acc[mi][2 * q + 5][r];
                                const float got = swap1(odd ? a0 : a1);
                                const unsigned pk = odd ? pk2(got, a1) : pk2(a0, got);
                                const int col = odd ? (16 * (2 * q + 1) + i - 1) : (16 * (2 * q) + i);
                                *(LAS unsigned*)(stg + lrow * 144 + col * 2) = pk; } }
#pragma unroll
                    for (int jj = 0; jj < 8; ++jj) { const int lrow = (lane >> 3) + 8 * jj, c = lane & 7, row = 64 * cw + lrow;
                        const v4u o = *(const LAS v4u*)(stg + lrow * 144 + 16 * c);
                        if (row < nrows) *(v4u*)(HG + (size_t)(off_e + rp + row) * DE + 64 * s + 8 * c) = o; }
                } else {
                    LAS unsigned char* stg = lds + XG_BUF + cw * 8704;
#pragma unroll
                    for (int h = 0; h < 2; ++h) {
#pragma unroll
                        for (int m2 = 0; m2 < 2; ++m2)
#pragma unroll
                            for (int r = 0; r < 4; ++r) { const int mi = 2 * h + m2, lrow = 16 * m2 + 4 * g + r; const float w = __int_as_float(rinfo[2 * (16 * mi + 4 * g + r) + 1]);
#pragma unroll
                                for (int q = 0; q < 4; ++q) { const float a0 = acc[mi][2 * q][r] * w, a1 = acc[mi][2 * q + 1][r] * w;
                                    const float got = swap1(odd ? a0 : a1);
                                    const unsigned pk = odd ? pk2(got, a1) : pk2(a0, got);
                                    const int col = odd ? (16 * (2 * q + 1) + i - 1) : (16 * (2 * q) + i);
                                    *(LAS unsigned*)(stg + lrow * 272 + col * 2) = pk; } }
#pragma unroll
                        for (int jj = 0; jj < 8; ++jj) { const int lrow = (lane >> 4) + 4 * jj, c = lane & 15, row = 64 * cw + 32 * h + lrow;
                            const v4u o = *(const LAS v4u*)(stg + lrow * 272 + 16 * c);
                            if (row < nrows) { const int as = rinfo[2 * (32 * h + lrow)]; *(v4u*)(YA + (size_t)as * D + 128 * s + 8 * c) = o; } }
                    }
                }
            }
        }
    }
}
template <bool UP>
__device__ __forceinline__ void xgemm_phase(const Args& a, LAS unsigned char* lds, int tid, int lane, int wave) {
    LAS int* cnts = (LAS int*)(lds + 2 * XG_BUF); LAS int* offs = cnts + 64; LAS int* eptab = offs + 68;
    expert_offsets((const unsigned*)(a.ws + WS_CTL) + CW_CNT, cnts, offs, eptab, XG_RM, tid);
    const int G = gridDim.x, bx = blockIdx.x; const int vcu = (G % 8 == 0) ? (bx % 8) * (G / 8) + bx / 8 : bx;
    constexpr int SH = UP ? 3 : 4;
    const int nitem = __builtin_amdgcn_readfirstlane(eptab[191]) << SH;
    for (int u = vcu; u < nitem; u += G) { const int ep = __builtin_amdgcn_readfirstlane(eptab[u >> SH]); const int e = ep & 255, rp = (ep >> 8) * XG_RM, s = u & ((1 << SH) - 1);
        xgemm_unit<UP>(a, lds, e, s, __builtin_amdgcn_readfirstlane(cnts[e]), __builtin_amdgcn_readfirstlane(offs[e]), rp, tid, lane, wave); }
}

__device__ __forceinline__ void phase11(const Args& a, int lane, int wave) {
    unsigned char* ws = a.ws;
    const float* MODF = (const float*)(ws + WS_MODF); const float* X1 = (const float*)(ws + WS_X1); const bf16* YA = (const bf16*)(ws + WS_YA); const float* g = a.in[I_GPOSTFFN];
    const int gw = blockIdx.x * NWAVES + wave, NGW = gridDim.x * NWAVES;
    v2u ya0[8], ya1[8], yb0[8], yb1[8]; f32x4 xa[8], xb[8];
#define P11_LOAD(y0_, y1_, x_, t_) do { _Pragma("unroll") for (int j_ = 0; j_ < 8; ++j_) { const int k_ = 4 * lane + 256 * j_; \
        y0_[j_] = *(const v2u*)(YA + (size_t)(2 * (t_)) * D + k_); y1_[j_] = *(const v2u*)(YA + (size_t)(2 * (t_) + 1) * D + k_); x_[j_] = *(const f32x4*)(X1 + (size_t)(t_) * D + k_); } } while (0)
#define P11_ROW(y0_, y1_, x_, t_) do { f32x4 v_[8]; float ss_ = 0.f; \
        _Pragma("unroll") for (int j_ = 0; j_ < 8; ++j_) { const v2u p_ = y0_[j_], q_ = y1_[j_]; \
            v_[j_].x = bf2f(p_.x & 0xffffu) + bf2f(q_.x & 0xffffu); v_[j_].y = bf2f(p_.x >> 16) + bf2f(q_.x >> 16); v_[j_].z = bf2f(p_.y & 0xffffu) + bf2f(q_.y & 0xffffu); v_[j_].w = bf2f(p_.y >> 16) + bf2f(q_.y >> 16); \
            ss_ += (v_[j_].x * v_[j_].x + v_[j_].y * v_[j_].y) + (v_[j_].z * v_[j_].z + v_[j_].w * v_[j_].w); } \
        ss_ = wave_sum(ss_); const float rstd_ = 1.0f / sqrtf(ss_ * (1.0f / D) + EPS); \
        _Pragma("unroll") for (int j_ = 0; j_ < 8; ++j_) { const int k_ = 4 * lane + 256 * j_; \
            const f32x4 gv_ = *(const f32x4*)(g + k_), gt_ = *(const f32x4*)(MODF + 5 * 2048 + k_); \
            *(f32x4*)(a.out + (size_t)(t_) * D + k_) = x_[j_] + gt_ * ((v_[j_] * rstd_) * gv_); } } while (0)
    int t = gw;
    if (t < T) P11_LOAD(ya0, ya1, xa, t);
    for (; t < T; t += 2 * NGW) {
        const int t2 = t + NGW, t3 = t + 2 * NGW;
        if (t2 < T) P11_LOAD(yb0, yb1, xb, t2);
        P11_ROW(ya0, ya1, xa, t);
        if (t2 < T) { if (t3 < T) P11_LOAD(ya0, ya1, xa, t3); P11_ROW(yb0, yb1, xb, t2); }
    }
#undef P11_LOAD
#undef P11_ROW
}

#ifndef MK_N_LAUNCHES
#define MK_N_LAUNCHES 1
#endif
constexpr int N_PHASES = 12;
constexpr int N_LAUNCHES = MK_N_LAUNCHES;
constexpr int MISC_OFF = 147456 - 256;

__global__ void __launch_bounds__(NTHR, 2) fwd_kernel(Args args) {
    extern __shared__ __attribute__((aligned(16))) unsigned char lds_raw[];
    LAS unsigned char* lds = (LAS unsigned char*)lds_raw;
    const int tid = threadIdx.x, lane = tid & 63, wave = __builtin_amdgcn_readfirstlane(tid >> 6);
    volatile LAS unsigned* MISC = (volatile LAS unsigned*)(lds + MISC_OFF);
    if (tid < 64) MISC[tid] = 0u;
    __syncthreads();
    unsigned char* ws = args.ws;
    unsigned* ctl = (unsigned*)(ws + WS_CTL);
    XcdBarrier bar; bar.bar = ctl + CW_BAR; bar.x = 0; bar.st = nullptr;
    if (N_LAUNCHES == 1) bar = xcd_barrier_post(ctl + CW_BAR, MISC + 8);
    const int lo = args.ph_lo, hi = args.ph_hi;
#ifndef ONLYP
#define ONLYP -1
#endif
#define IN(k) ((ONLYP < 0) ? (lo <= (k) && (k) < hi) : ((k) == ONLYP))
#define SEAM(k) do { if (IN(k) && IN((k) + 1)) xcd_barrier(bar); } while (0)
    if (IN(0)) { phase0<0>(args, lds, tid, lane, wave, (int)blockIdx.x * NWAVES + wave, (int)gridDim.x * NWAVES); } SEAM(0);
    if (IN(1)) { phase1(args, lds, tid, lane, wave); } SEAM(1);
    if (IN(2)) {
        pg8::Gemm g{(const pg8::bf16_t*)(ws + WS_HN), (const pg8::bf16_t*)(ws + WS_WINT), T, NIN, D};
        pg8::StaticOrder S; S.init(T, NIN, gridDim.x, (int)blockIdx.x);
        EpiIn E{(bf16*)(ws + WS_QA), (bf16*)(ws + WS_KA), (bf16*)(ws + WS_VA), (bf16*)(ws + WS_MQ0), (bf16*)(ws + WS_MK0), (bf16*)(ws + WS_MV), (bf16*)(ws + WS_MO), (const float*)(ws + WS_COS), (const float*)(ws + WS_SIN)};
        if ((int)blockIdx.x >= (int)gridDim.x - 4) gate_prep(args, lds, (int)blockIdx.x - ((int)gridDim.x - 4), tid, lane, wave);
        pg8::gemm_phase<EpiIn, pg8::StaticOrder, true, true>(lds, g, S, E);
        { const int G_ = (int)gridDim.x, rem_ = (704 % G_), first_ = (rem_ == 0) ? 0 : rem_, nl_ = G_ - first_;
          if ((int)blockIdx.x >= first_) { __syncthreads(); phase0<1>(args, lds, tid, lane, wave, ((int)blockIdx.x - first_) * NWAVES + wave, nl_ * NWAVES); } }
    } SEAM(2);
    if (IN(3)) {
        conv_phase(args, tid);
        attn_phase(args, lds, tid, lane, wave);
    } SEAM(3);
    if (IN(4)) {
        for (int it = blockIdx.x; it < 12 * (NSEG - 1); it += gridDim.x) { const int hh_ = it / (3 * (NSEG - 1)), eh_ = (it / (NSEG - 1)) % 3, sg_ = it % (NSEG - 1);
            if (eh_ == 2) mlstm_item<true, true>(args, lds, hh_, eh_, sg_, tid, lane, wave); else mlstm_item<true, false>(args, lds, hh_, eh_, sg_, tid, lane, wave); }
        { constexpr int NMA = 12 * (NSEG - 1); const int G_ = (int)gridDim.x;
          if (G_ > NMA) { if ((int)blockIdx.x >= NMA) modf_phase(args, tid, (int)blockIdx.x - NMA, G_ - NMA); } else modf_phase(args, tid, (int)blockIdx.x, G_); }
        xcd_barrier(bar);
        for (int it = blockIdx.x; it < 12 * NSEG; it += gridDim.x) { const int hh_ = it / (3 * NSEG), eh_ = (it / NSEG) % 3, sg_ = it % NSEG;
            if (eh_ == 2) mlstm_item<false, true>(args, lds, hh_, eh_, sg_, tid, lane, wave); else mlstm_item<false, false>(args, lds, hh_, eh_, sg_, tid, lane, wave); }
    } SEAM(4);
    if (IN(5)) { mlstm_norm_phase(args, lane, wave); } SEAM(5);
    if (IN(6)) {
        pg8::Gemm g{(const pg8::bf16_t*)(ws + WS_YMIX), (const pg8::bf16_t*)(ws + WS_WOUTT), T, D, D};
        pg8::StaticOrder S; S.init(T, D, gridDim.x, (int)blockIdx.x);
        EpiY E{(float*)(ws + WS_Y)};
        pg8::gemm_phase<EpiY, pg8::StaticOrder, true, true>(lds, g, S, E);
    } SEAM(6);
    if (IN(7)) { phase7(args, lds, tid, lane, wave); } if (IN(7) && IN(9)) xcd_barrier(bar);
    if (IN(9)) { xgemm_phase<true>(args, lds, tid, lane, wave); } SEAM(9);
    if (IN(10)) { xgemm_phase<false>(args, lds, tid, lane, wave); } SEAM(10);
    if (IN(11)) { phase11(args, lane, wave); }
#undef IN
#undef SEAM
}

extern "C" void kernel_launch(void* const* d_in, const int* in_sizes, int n_in, void* d_out, int out_size, void* d_ws, size_t ws_size, hipStream_t stream) {
    static int grid = 0;
    if (grid == 0) {
        if (n_in != 22 || out_size != T * D || ws_size < WS_END) { fprintf(stderr, "kernel_launch: unexpected shapes: n_in %d out %d ws %zu (need %zu)\n", n_in, out_size, ws_size, (size_t)WS_END); grid = -1; return; }
        int dev = 0, cus = 0;
        if (hipGetDevice(&dev) != hipSuccess || hipDeviceGetAttribute(&cus, hipDeviceAttributeMultiprocessorCount, dev) != hipSuccess) { grid = -1; return; }
        if (hipFuncSetAttribute((const void*)fwd_kernel, hipFuncAttributeMaxDynamicSharedMemorySize, LDS_BYTES) != hipSuccess) { fprintf(stderr, "kernel_launch: hipFuncSetAttribute failed\n"); grid = -1; return; }
        int per_cu = 0;
        if (hipOccupancyMaxActiveBlocksPerMultiprocessor(&per_cu, (const void*)fwd_kernel, NTHR, LDS_BYTES) != hipSuccess || per_cu < 1) fprintf(stderr, "kernel_launch: occupancy query says %d\n", per_cu);
        (void)hipGetLastError();
        grid = cus;
    }
    if (grid < 0) return;
    (void)hipMemsetAsync((char*)d_ws + WS_CTL, 0, CTL_ZERO_BYTES, stream);
    Args a{};
    for (int i = 0; i < 22; ++i) a.in[i] = (const float*)d_in[i];
    a.out = (float*)d_out; a.ws = (unsigned char*)d_ws;
    if (N_LAUNCHES == 1) { a.ph_lo = 0; a.ph_hi = N_PHASES; hipLaunchKernelGGL(fwd_kernel, dim3(grid), dim3(NTHR), LDS_BYTES, stream, a); }
    else for (int p = 0; p < N_PHASES; ++p) { a.ph_lo = p; a.ph_hi = p + 1; hipLaunchKernelGGL(fwd_kernel, dim3(grid), dim3(NTHR), LDS_BYTES, stream, a); }
}
```

```cpp
#include <hip/hip_runtime.h>
#include <cstdio>
#include <cstdint>
namespace pg8 {
#define PG8_LAS __attribute__((address_space(3)))
typedef unsigned short bf16_t;
typedef short bf16x8 __attribute__((ext_vector_type(8)));
typedef float f32x4 __attribute__((ext_vector_type(4)));
typedef unsigned u32x4 __attribute__((ext_vector_type(4)));
constexpr int BM = 256, BK = 64, HALF = 128, HTB = HALF * BK * 2  , STAGE_BYTES = 8 * HTB, NXCD = 8, WGM = 8;

__host__ __device__ __forceinline__ int lds_byte(int r, int c) { const int st = (r >> 4) * 2 + (c >> 5), rr = r & 15, cc = c & 31, ob = rr * 64 + cc * 2; return st * 1024 + (ob ^ (((ob >> 9) & 1) << 5)); }
__host__ __device__ __forceinline__ void stage_rc(int b, int& R, int& C) { const int st = b / 1024, sb = b % 1024, swz = sb ^ (((sb >> 9) & 1) << 5); R = (st >> 1) * 16 + swz / 64; C = (st & 1) * 32 + (swz % 64) / 2; }
__host__ __device__ __forceinline__ int perm32(int rho) { const int n = rho >> 4, i = rho & 15; return 8 * (i >> 2) + 4 * n + (i & 3); }

__device__ __forceinline__ unsigned cvt_pk_bf16(float lo, float hi) { unsigned r; asm volatile("v_cvt_pk_bf16_f32 %0, %1, %2" : "=v"(r) : "v"(lo), "v"(hi)); return r; }
struct Unit { int pm, pn; };
struct Gemm { const bf16_t* A; const bf16_t* Bt; int M, N, K; };

struct StaticOrder {
    int nM, nN, nwg, G, c;
    __host__ __device__ void init(int M, int N, int G_, int c_) { nM = M / BM; nN = N / BM; nwg = nM * nN; G = G_; c = c_; }
    __host__ __device__ bool next(int i, Unit& u) const {
        const long L = (long)i * G + c; if (L >= nwg) return false;
        int wgid = (int)L; { const int q = nwg / NXCD, r = nwg % NXCD, xcd = wgid % NXCD, off = wgid / NXCD; wgid = (xcd < r ? xcd * (q + 1) : r * (q + 1) + (xcd - r) * q) + off; }
        const int nig = WGM * nN, gid = wgid / nig, fm = gid * WGM, gsz = (nM - fm) < WGM ? (nM - fm) : WGM;
        u.pm = fm + ((wgid % nig) % gsz); u.pn = (wgid % nig) / gsz; return true;
    }
    __device__ __forceinline__ void a_ready(const Unit&) const {}
    __device__ __forceinline__ void done(const Unit&) const {}
};

template <class Epi, class Sched, bool ALIGN_EPI = false, bool SP2 = false>
__device__ __forceinline__ void gemm_phase(PG8_LAS unsigned char* lds, const Gemm g, const Sched& S, const Epi& E) {
    const int tid = threadIdx.x, wid = __builtin_amdgcn_readfirstlane(tid >> 6), lane = tid & 63, wr = wid >> 2, wc = wid & 3, fr = lane & 15, fq = lane >> 4;
    const int K = g.K, nt = K / BK;
    unsigned voffA[2], voffB[2];
#pragma unroll
    for (int i = 0; i < 2; ++i) { int R, C; stage_rc(tid * 16 + i * 8192, R, C); const int Rb = Epi::PERM ? ((R & ~31) + perm32(R & 31)) : R;
        voffA[i] = (unsigned)(R * K + C) * 2u; voffB[i] = (unsigned)(Rb * K + C) * 2u; }
    const size_t kstep = (size_t)(BK * 2);
    const size_t hstep = (size_t)HALF * K * 2;
    const size_t tstep = 2 * hstep;
    const unsigned ldsw = (unsigned)wid * 1024u;
    const int aoff = lds_byte(wr * 64 + fr, fq * 8), boff = lds_byte(wc * 32 + fr, fq * 8);
#define PG8_SA(b, h) (((b) * 2 + (h)) * HTB)
#define PG8_SB(b, h) ((4 + (b) * 2 + (h)) * HTB)
#define PG8_STAGE(bufoff, gbase, voff) do { _Pragma("unroll") for (int _i = 0; _i < 2; ++_i) \
        __builtin_amdgcn_global_load_lds((const unsigned*)((const char*)(gbase) + (voff)[_i]), (PG8_LAS unsigned*)(lds + (bufoff) + ldsw + _i * 8192), 16, 0, 0); } while (0)
#define PG8_LDA(dst, b, h) do { _Pragma("unroll") for (int m = 0; m < 4; ++m) _Pragma("unroll") for (int k = 0; k < 2; ++k) dst[m][k] = *(const PG8_LAS bf16x8*)(lds + PG8_SA(b, h) + aoff + m * 2048 + k * 1024); } while (0)
#define PG8_LDB(dst, b, h) do { _Pragma("unroll") for (int n = 0; n < 2; ++n) _Pragma("unroll") for (int k = 0; k < 2; ++k) dst[n][k] = *(const PG8_LAS bf16x8*)(lds + PG8_SB(b, h) + boff + n * 2048 + k * 1024); } while (0)
#define PG8_MMA(ai, bj, At, Bt) do { __builtin_amdgcn_s_setprio(1); _Pragma("unroll") for (int m = 0; m < 4; ++m) _Pragma("unroll") for (int n = 0; n < 2; ++n) _Pragma("unroll") for (int k = 0; k < 2; ++k) \
        acc[ai][bj][m][n] = __builtin_amdgcn_mfma_f32_16x16x32_bf16(Bt[n][k], At[m][k], acc[ai][bj][m][n], 0, 0, 0); __builtin_amdgcn_s_setprio(0); } while (0)
#define PG8_WAIT_V(n) asm volatile("s_waitcnt vmcnt(" #n ")" ::: "memory")
#define PG8_WAIT_L(n) asm volatile("s_waitcnt lgkmcnt(" #n ")" ::: "memory")
#define PG8_BAR __builtin_amdgcn_s_barrier()
#define PG8_SCHED __builtin_amdgcn_sched_barrier(0)
    Unit cur, nxt; int ui = 0;
    if (!S.next(0, cur)) return;
    f32x4 acc[2][2][4][2];
#pragma unroll
    for (int a = 0; a < 2; ++a)
#pragma unroll
        for (int b = 0; b < 2; ++b)
#pragma unroll
            for (int m = 0; m < 4; ++m)
#pragma unroll
                for (int n = 0; n < 2; ++n) acc[a][b][m][n] = (f32x4){0.f, 0.f, 0.f, 0.f};
    bf16x8 At[4][2], B0[2][2], B1[2][2];
    const char* cA = (const char*)g.A + (size_t)cur.pm * tstep; const char* cB = (const char*)g.Bt + (size_t)cur.pn * tstep;
    S.a_ready(cur);
    if constexpr (SP2) {
        PG8_STAGE(PG8_SB(0, 0), cB, voffB); PG8_STAGE(PG8_SB(0, 1), cB + hstep, voffB); PG8_STAGE(PG8_SA(0, 0), cA, voffA); PG8_STAGE(PG8_SA(0, 1), cA + hstep, voffA);
        if (wr == 1) PG8_BAR;
        PG8_WAIT_V(2); PG8_BAR;
        PG8_STAGE(PG8_SB(1, 0), cB + kstep, voffB); PG8_STAGE(PG8_SA(1, 0), cA + kstep, voffA); PG8_STAGE(PG8_SB(1, 1), cB + hstep + kstep, voffB);
        PG8_WAIT_V(6); PG8_BAR;
    } else {
        PG8_STAGE(PG8_SB(0, 0), cB, voffB); PG8_STAGE(PG8_SA(0, 0), cA, voffA); PG8_STAGE(PG8_SB(0, 1), cB + hstep, voffB); PG8_STAGE(PG8_SA(0, 1), cA + hstep, voffA);
        if (wr == 1) PG8_BAR;
        PG8_WAIT_V(4); PG8_BAR;
        PG8_STAGE(PG8_SB(1, 0), cB + kstep, voffB); PG8_STAGE(PG8_SA(1, 0), cA + kstep, voffA); PG8_STAGE(PG8_SB(1, 1), cB + hstep + kstep, voffB);
        PG8_WAIT_V(6); PG8_BAR;
    }
    for (;;) {
        const bool has_next = S.next(ui + 1, nxt);
        const char* nA = has_next ? (const char*)g.A + (size_t)nxt.pm * tstep : cA; const char* nB = has_next ? (const char*)g.Bt + (size_t)nxt.pn * tstep : cB;
        for (int t = 0; t < nt; t += 2) {
            const bool last = (t == nt - 2);
            const char* a1 = cA + (size_t)(t + 1) * kstep;
            const char* a2 = last ? nA : cA + (size_t)(t + 2) * kstep; const char* b2 = last ? nB : cB + (size_t)(t + 2) * kstep;
            const char* a3 = a2 + kstep; const char* b3 = b2 + kstep;
            if (last && has_next) S.a_ready(nxt);
            if constexpr (SP2) {
            PG8_LDB(B0, 0, 0); PG8_LDB(B1, 0, 1); PG8_SCHED; PG8_LDA(At, 0, 0); PG8_STAGE(PG8_SA(1, 1), a1 + hstep, voffA);
            PG8_WAIT_V(8); PG8_WAIT_L(0); PG8_BAR; PG8_MMA(0, 0, At, B0); PG8_MMA(0, 1, At, B1); PG8_BAR; PG8_SCHED;
            PG8_LDA(At, 0, 1); PG8_STAGE(PG8_SB(0, 0), b2, voffB); PG8_STAGE(PG8_SB(0, 1), b2 + hstep, voffB); PG8_STAGE(PG8_SA(0, 0), a2, voffA);
            PG8_WAIT_V(8); PG8_WAIT_L(0); PG8_BAR; PG8_MMA(1, 0, At, B0); PG8_MMA(1, 1, At, B1); PG8_BAR; PG8_SCHED;
            PG8_LDB(B0, 1, 0); PG8_LDB(B1, 1, 1); PG8_SCHED; PG8_LDA(At, 1, 0); PG8_STAGE(PG8_SA(0, 1), a2 + hstep, voffA);
            PG8_WAIT_V(8); PG8_WAIT_L(0); PG8_BAR; PG8_MMA(0, 0, At, B0); PG8_MMA(0, 1, At, B1); PG8_BAR; PG8_SCHED;
            PG8_LDA(At, 1, 1); PG8_STAGE(PG8_SB(1, 0), b3, voffB); PG8_STAGE(PG8_SB(1, 1), b3 + hstep, voffB); PG8_STAGE(PG8_SA(1, 0), a3, voffA);
            PG8_WAIT_V(8); PG8_WAIT_L(0); PG8_BAR; PG8_MMA(1, 0, At, B0); PG8_MMA(1, 1, At, B1); PG8_BAR; PG8_SCHED;
            } else {
            PG8_LDB(B0, 0, 0); PG8_SCHED; PG8_LDA(At, 0, 0); PG8_STAGE(PG8_SA(1, 1), a1 + hstep, voffA);
            PG8_WAIT_L(8); PG8_BAR; PG8_WAIT_L(0); PG8_MMA(0, 0, At, B0); PG8_BAR; PG8_SCHED;
            PG8_LDB(B1, 0, 1); PG8_STAGE(PG8_SB(0, 0), b2, voffB);
            PG8_BAR; PG8_WAIT_L(0); PG8_MMA(0, 1, At, B1); PG8_BAR;
            PG8_LDA(At, 0, 1); PG8_STAGE(PG8_SA(0, 0), a2, voffA);
            PG8_BAR; PG8_WAIT_L(0); PG8_MMA(1, 0, At, B0); PG8_BAR; PG8_SCHED;
            PG8_STAGE(PG8_SB(0, 1), b2 + hstep, voffB);
            PG8_WAIT_V(6); PG8_BAR; PG8_MMA(1, 1, At, B1); PG8_BAR;
            PG8_LDB(B0, 1, 0); PG8_SCHED; PG8_LDA(At, 1, 0); PG8_STAGE(PG8_SA(0, 1), a2 + hstep, voffA);
            PG8_WAIT_L(8); PG8_BAR; PG8_WAIT_L(0); PG8_MMA(0, 0, At, B0); PG8_BAR; PG8_SCHED;
            PG8_LDB(B1, 1, 1); PG8_STAGE(PG8_SB(1, 0), b3, voffB);
            PG8_BAR; PG8_WAIT_L(0); PG8_MMA(0, 1, At, B1); PG8_BAR;
            PG8_LDA(At, 1, 1); PG8_STAGE(PG8_SA(1, 0), a3, voffA);
            PG8_BAR; PG8_WAIT_L(0); PG8_MMA(1, 0, At, B0); PG8_BAR; PG8_SCHED;
            PG8_STAGE(PG8_SB(1, 1), b3 + hstep, voffB);
            PG8_WAIT_V(6); PG8_BAR; PG8_MMA(1, 1, At, B1); PG8_BAR;
            }
        }
        if constexpr (ALIGN_EPI) { if (wr == 0) PG8_BAR; }
        if constexpr (!Epi::AFTER_DRAIN) { E(acc, cur, wr, wc, fr, fq); S.done(cur); }
        if (!has_next) break;
#pragma unroll
        for (int a = 0; a < 2; ++a)
#pragma unroll
            for (int b = 0; b < 2; ++b)
#pragma unroll
                for (int m = 0; m < 4; ++m)
#pragma unroll
                    for (int n = 0; n < 2; ++n) acc[a][b][m][n] = (f32x4){0.f, 0.f, 0.f, 0.f};
        cur = nxt; cA = nA; cB = nB; ++ui;
        if constexpr (ALIGN_EPI) { if (wr == 1) PG8_BAR; }
    }
    PG8_WAIT_V(0);
    if constexpr (!ALIGN_EPI) { if (wr == 0) PG8_BAR; }
    PG8_BAR;
    if constexpr (Epi::AFTER_DRAIN) { E.fused(acc, cur, wr, wc, fr, fq, lds, wid, lane); S.done(cur); }
#undef PG8_SA
#undef PG8_SB
#undef PG8_STAGE
#undef PG8_LDA
#undef PG8_LDB
#undef PG8_MMA
#undef PG8_WAIT_V
#undef PG8_WAIT_L
#undef PG8_BAR
#undef PG8_SCHED
}
}
#define GAS __attribute__((address_space(1)))
#define LAS __attribute__((address_space(3)))
typedef unsigned short bf16;
typedef unsigned v4u __attribute__((ext_vector_type(4)));
typedef unsigned v2u __attribute__((ext_vector_type(2)));
typedef float f32x4 __attribute__((ext_vector_type(4)));
typedef float f32x2 __attribute__((ext_vector_type(2)));
typedef short bf16x8 __attribute__((ext_vector_type(8)));
typedef short s16x4 __attribute__((ext_vector_type(4)));

constexpr int T = 8192, D = 2048, NQW = 1024, NKVW = 256, MW = 1024, INW = 5640, NIN = 5632;
constexpr int NEXP = 64, DE = 512;
constexpr int NWAVES = 8, NTHR = 512;
constexpr float EPS = 1e-6f;
constexpr int LDS_BYTES = 147456;
constexpr size_t MiB = 1u << 20;
constexpr size_t WS_CTL = 0, CTL_ZERO_BYTES = 64 * 1024;
constexpr size_t WS_MODP = 1 * MiB;
constexpr size_t WS_MODP0 = 13 * MiB;
constexpr size_t WS_MODF = 3 * MiB;
constexpr size_t WS_COS = 4 * MiB, WS_SIN = 5 * MiB;
constexpr size_t WS_GATES = 6 * MiB;
constexpr size_t WS_GA = 6 * MiB + 256 * 1024, WS_GB = WS_GA + 128 * 1024, WS_GM = WS_GB + 128 * 1024;
constexpr size_t WS_CS = WS_GM + 128 * 1024;
constexpr size_t WS_DEN = WS_CS + 64 * 1024;
constexpr size_t WS_ROUTE = 7 * MiB;
constexpr size_t WS_WCH = 12 * MiB;
constexpr size_t WS_ABC = 14 * MiB;
constexpr size_t WS_PAN = 11 * MiB;
constexpr size_t WS_HIST = 10 * MiB;
constexpr size_t WS_LISTS = 8 * MiB;
constexpr int LCAP = 8192;
constexpr size_t WS_WINT = 16 * MiB, WS_WOUTT = 38 * MiB, WS_HN = 48 * MiB;
constexpr size_t WS_QA = 80 * MiB, WS_KA = 96 * MiB, WS_VA = 100 * MiB, WS_MQ0 = 104 * MiB, WS_MK0 = 120 * MiB, WS_MV = 136 * MiB, WS_MO = 152 * MiB;
constexpr size_t WS_MQ = 168 * MiB, WS_MK = 184 * MiB, WS_NUM = 200 * MiB, WS_YMIX = 232 * MiB, WS_Y = 264 * MiB, WS_X1 = 328 * MiB;
constexpr size_t WS_XG = 80 * MiB;
constexpr size_t WS_HG = 208 * MiB;
constexpr size_t WS_YA = 392 * MiB;
constexpr size_t WS_W13T = 456 * MiB;
constexpr size_t WS_W2T = 712 * MiB;
constexpr size_t WS_END = 840 * MiB;
constexpr int CW_TMO = 0, CW_BAR = 4096, CW_CNT = 8192  ;

#define RLX_AGENT __ATOMIC_RELAXED, __HIP_MEMORY_SCOPE_AGENT
__device__ __forceinline__ float bf2f(unsigned v) { return __uint_as_float(v << 16); }
typedef float f32x2_t __attribute__((ext_vector_type(2))); typedef __bf16 bf16x2_t __attribute__((ext_vector_type(2)));
__device__ __forceinline__ unsigned pk2(float lo, float hi) { f32x2_t v = {lo, hi}; bf16x2_t b = __builtin_convertvector(v, bf16x2_t); return __builtin_bit_cast(unsigned, b); }
__device__ __forceinline__ v2u pk4(f32x4 v) { v2u r; r.x = pk2(v.x, v.y); r.y = pk2(v.z, v.w); return r; }
__device__ __forceinline__ float wave_sum(float v) {
#pragma unroll
    for (int o = 1; o < 64; o <<= 1) v += __shfl_xor(v, o);
    return v;
}
__device__ __forceinline__ float wave_max(float v) {
#pragma unroll
    for (int o = 1; o < 64; o <<= 1) v = fmaxf(v, __shfl_xor(v, o));
    return v;
}
__device__ __forceinline__ float siluf(float v) { return v * __builtin_amdgcn_rcpf(1.f + __expf(-v)); }
__device__ __forceinline__ float sigmoidf_(float v) { return __builtin_amdgcn_rcpf(1.f + __expf(-v)); }
__device__ __forceinline__ bf16x8 cat8(s16x4 a, s16x4 b) { bf16x8 r; r[0] = a[0]; r[1] = a[1]; r[2] = a[2]; r[3] = a[3]; r[4] = b[0]; r[5] = b[1]; r[6] = b[2]; r[7] = b[3]; return r; }
__device__ __forceinline__ s16x4 tr16(const LAS unsigned char* p) { return __builtin_bit_cast(s16x4, __builtin_amdgcn_ds_read_tr16_b64_v4i16((LAS s16x4*)p)); }
__device__ __forceinline__ bf16x8 pack8(f32x4 a, f32x4 b) { v4u r; r.x = pk2(a.x, a.y); r.y = pk2(a.z, a.w); r.z = pk2(b.x, b.y); r.w = pk2(b.z, b.w); return __builtin_bit_cast(bf16x8, r); }
__device__ __forceinline__ float swap1(float x) { return __int_as_float(__builtin_amdgcn_update_dpp(0, __float_as_int(x), 0xB1, 0xF, 0xF, true)); }
#define MFMA16(a, b, c) __builtin_amdgcn_mfma_f32_16x16x32_bf16((a), (b), (c), 0, 0, 0)

__device__ const float ROPE_INV[32] = {1.000000000e+00f, 7.498942018e-01f, 5.623413324e-01f, 4.216965139e-01f, 3.162277639e-01f, 2.371373773e-01f, 1.778279394e-01f, 1.333521456e-01f, 1.000000015e-01f, 7.498942316e-02f, 5.623413250e-02f, 4.216964915e-02f, 3.162277490e-02f, 2.371373773e-02f, 1.778279431e-02f, 1.333521400e-02f, 9.999999776e-03f, 7.498942316e-03f, 5.623413250e-03f, 4.216964822e-03f, 3.162277630e-03f, 2.371373819e-03f, 1.778279431e-03f, 1.333521446e-03f, 1.000000047e-03f, 7.498941850e-04f, 5.623413017e-04f, 4.216965172e-04f, 3.162277571e-04f, 2.371373703e-04f, 1.778279402e-04f, 1.333521504e-04f};

struct Args { const float* in[22]; float* out; unsigned char* ws; int ph_lo, ph_hi; };
enum { I_X = 0, I_C, I_WADA, I_BADA, I_GPREMIX, I_GPOSTMIX, I_GPREFFN, I_GPOSTFFN, I_WIN, I_BGATES, I_CONVW, I_CONVB, I_SINKS, I_MNORM, I_WOUT, I_WGROUP, I_BGROUP, I_WEXPERT, I_BEXPERT, I_W1, I_W3, I_W2 };
#define XBLAS LAS
#define XB_TMO      128
#define XB_XCNT(j)  (256  + 64 * (j))
#define XB_XSUB(j)  (1280 + 64 * (j))
#define XB_XGEN(j)  (2304 + 64 * (j))
#define XB_TOP      3328
#define XB_TOPGEN   3392
#define XCD_BAR_WORDS 3456
#define XB_SPIN_CAP (1u << 18)

__device__ __forceinline__ unsigned xb_ld(unsigned* p)              { return __hip_atomic_load(p, __ATOMIC_RELAXED, __HIP_MEMORY_SCOPE_AGENT); }
__device__ __forceinline__ unsigned xb_add(unsigned* p, unsigned v) { return __hip_atomic_fetch_add(p, v, __ATOMIC_RELAXED, __HIP_MEMORY_SCOPE_AGENT); }
__device__ __forceinline__ unsigned xb_xcc_id() { return (unsigned)__builtin_amdgcn_s_getreg((3 << 11) | 20) & 0xFu; }
#define XB_SPIN(cond, bar) do { unsigned _sp = 0; while (cond) { __builtin_amdgcn_s_sleep(1); \
    if ((++_sp & 255u) == 0u) { if (xb_ld(&(bar)[XB_TMO])) break; if (_sp > XB_SPIN_CAP) { atomicAdd(&(bar)[XB_TMO], 1u); break; } } } } while (0)

struct XcdBarrier {
    unsigned* bar; unsigned x;
    volatile LAS unsigned* st;
};

__device__ __forceinline__ XcdBarrier xcd_barrier_post(unsigned* bar, volatile LAS unsigned* st) {
    XcdBarrier b; b.bar = bar; b.x = xb_xcc_id(); b.st = st;
    if (threadIdx.x == 0) (void)xb_add(&bar[XB_XCNT(b.x)], 1u);
    return b;
}
__device__ __forceinline__ void xcd_barrier_complete(unsigned* bar, unsigned x, unsigned& nloc, unsigned& nx) {
    const unsigned G = gridDim.x * gridDim.y * gridDim.z;
    unsigned sum, cnt, mine, sp = 0u;
    for (;;) {
        sum = 0u; cnt = 0u; mine = 0u;
#pragma unroll
        for (unsigned j = 0; j < 16; ++j) { const unsigned c = xb_ld(&bar[XB_XCNT(j)]); sum += c; cnt += (c > 0u) ? 1u : 0u; mine = (j == x) ? c : mine; }
        if (sum == G) break;
        __builtin_amdgcn_s_sleep(1);
        if ((++sp & 255u) == 0u) { if (xb_ld(&bar[XB_TMO])) break; if (sp > XB_SPIN_CAP) { atomicAdd(&bar[XB_TMO], 1u); break; } }
    }
    nloc = mine > 0u ? mine : 1u; nx = cnt > 0u ? cnt : 1u;
}

__device__ __forceinline__ void xcd_barrier(const XcdBarrier& b) {
    asm volatile("s_waitcnt vmcnt(0)" ::: "memory");
    __syncthreads();
    if (threadIdx.x == 0) {
        unsigned* bar = b.bar;
        __builtin_amdgcn_s_waitcnt(0);
        unsigned nloc = b.st[0], nx = b.st[1];
        if (nloc == 0u) { xcd_barrier_complete(bar, b.x, nloc, nx); b.st[0] = nloc; b.st[1] = nx; }
        const unsigned old = xb_add(&bar[XB_XSUB(b.x)], 1u);
        const unsigned gen = old / nloc;
        if (old + 1u == (gen + 1u) * nloc) {
            __builtin_amdgcn_fence(__ATOMIC_RELEASE, "agent");
            asm volatile("s_waitcnt vmcnt(0)" ::: "memory");
            const unsigned og = xb_add(&bar[XB_TOP], 1u);
            const unsigned tg = og / nx;
            if (og + 1u == (tg + 1u) * nx) xb_add(&bar[XB_TOPGEN], 1u);
            else XB_SPIN(xb_ld(&bar[XB_TOPGEN]) == tg, bar);
            __builtin_amdgcn_fence(__ATOMIC_ACQUIRE, "agent");
            xb_add(&bar[XB_XGEN(b.x)], 1u);
            asm volatile("s_waitcnt vmcnt(0)" ::: "memory");
        } else {
            XB_SPIN(xb_ld(&bar[XB_XGEN(b.x)]) == gen, bar);
            __builtin_amdgcn_fence(__ATOMIC_ACQUIRE, "agent");
            asm volatile("s_waitcnt vmcnt(0)" ::: "memory");
        }
    }
    __syncthreads();
}
__device__ __forceinline__ int swap45(int p) { return (p & ~48) | ((p & 16) << 1) | ((p & 32) >> 1); }
template <int MODE>
__device__ __forceinline__ void transpose_item(const float* W, int ldw, int K, bf16* WT, int dbase, LAS float* scr_, int kb, int nb, int lane) {
    LAS unsigned char* scr = (LAS unsigned char*)scr_;
    const int k0 = 64 * kb, n0 = 64 * nb, kq = lane >> 4, nq = lane & 15;
    f32x4 v[16];
    const float* wp = W + (size_t)(k0 + 16 * kq) * ldw + n0 + 4 * nq;
#pragma unroll
    for (int j = 0; j < 16; ++j) v[j] = *(const f32x4*)(wp + (size_t)j * ldw);
#pragma unroll
    for (int c = 0; c < 4; ++c) { v4u lo, hi;
        lo.x = pk2(v[0][c], v[1][c]); lo.y = pk2(v[2][c], v[3][c]); lo.z = pk2(v[4][c], v[5][c]); lo.w = pk2(v[6][c], v[7][c]);
        hi.x = pk2(v[8][c], v[9][c]); hi.y = pk2(v[10][c], v[11][c]); hi.z = pk2(v[12][c], v[13][c]); hi.w = pk2(v[14][c], v[15][c]);
        const int n = 4 * nq + c, sw = nq & 7;
        *(LAS v4u*)(scr + n * 128 + 16 * ((2 * kq) ^ sw)) = lo; *(LAS v4u*)(scr + n * 128 + 16 * ((2 * kq + 1) ^ sw)) = hi; }
    asm volatile("s_waitcnt lgkmcnt(0)" ::: "memory");
    const int ch = lane & 7;
#pragma unroll
    for (int jj = 0; jj < 8; ++jj) { const int n = (lane >> 3) + 8 * jj;
        const v4u o = *(const LAS v4u*)(scr + n * 128 + 16 * (ch ^ ((n >> 2) & 7)));
        const int ns = n0 + n; int dr;
        if (MODE == 0) dr = ns; else dr = (ns < 1280) ? ((ns & ~63) | swap45(ns & 63)) : ns;
        *(v4u*)(WT + (size_t)(dbase + dr) * K + k0 + 8 * ch) = o; }
    asm volatile("s_waitcnt lgkmcnt(0)" ::: "memory");
}
template <int PART> __device__ __forceinline__ void phase0(const Args& a, LAS unsigned char* lds, int tid, int lane, int wave, int gw, int NGW) {
    unsigned char* ws = a.ws;
    LAS float* scr = (LAS float*)(lds + wave * 16384);
    {
        const float* c = a.in[I_C]; const float* W = a.in[I_WADA]; float* MODP = (float*)(ws + WS_MODP);
        constexpr int NB0 = 16, NBN = PART == 0 ? NB0 : 48 - NB0;
        if (PART == 0) {
            float* MODP0 = (float*)(ws + WS_MODP0);
            for (int wi = blockIdx.x; wi < 256; wi += gridDim.x) { const int kg = wi >> 6, cb = wi & 63, kb = 8 * kg + wave, r4 = lane >> 4, c4 = lane & 15;
                const float sv = siluf(c[64 * kb + lane]);
                f32x4 acc = {0.f, 0.f, 0.f, 0.f}, wv[16];
                const float* wp = W + (size_t)(64 * kb + r4) * 12288 + 64 * cb + 4 * c4;
#pragma unroll
                for (int i = 0; i < 16; ++i) wv[i] = *(const f32x4*)(wp + (size_t)(4 * i) * 12288);
#pragma unroll
                for (int i = 0; i < 16; ++i) acc += __shfl(sv, r4 + 4 * i) * wv[i];
#pragma unroll
                for (int q = 0; q < 4; ++q) { acc[q] += __shfl_xor(acc[q], 16); acc[q] += __shfl_xor(acc[q], 32); }
                if (lane < 16) *(LAS f32x4*)(scr + 4 * lane) = acc;
                __syncthreads();
                if (tid < 64) { float s = 0.f;
#pragma unroll
                    for (int w = 0; w < 8; ++w) s += *(const LAS float*)(lds + w * 16384 + 4 * tid);
                    MODP0[(size_t)(64 * cb + tid) * 4 + kg] = s; }
                __syncthreads(); }
        } else
        for (int it = gw; it < 32 * NBN; it += NGW) {
            const int kb = it / NBN, nb = it % NBN + (PART == 0 ? 0 : NB0);
            const float sv = siluf(c[64 * kb + lane]);
            f32x4 acc = {0.f, 0.f, 0.f, 0.f};
            const float* wp = W + (size_t)(64 * kb) * 12288 + 256 * nb + 4 * lane;
#pragma unroll 8
            for (int kk = 0; kk < 64; ++kk) { const float s = __shfl(sv, kk); const f32x4 w = *(const f32x4*)(wp + (size_t)kk * 12288); acc += s * w; }
            { float* mp = MODP + (size_t)(256 * nb + 4 * lane) * 32 + kb;
              mp[0] = acc.x; mp[32] = acc.y; mp[64] = acc.z; mp[96] = acc.w; }
        }
    }
    if (PART == 0) { const float* W = a.in[I_WIN]; v4u* PANF = (v4u*)(ws + WS_PAN);
        for (int idx = blockIdx.x * NTHR + tid; idx < 256 * 16; idx += gridDim.x * NTHR) { const int n = idx & 15, kk = idx >> 4, k0 = 8 * kk; float v[8];
#pragma unroll
            for (int j = 0; j < 8; ++j) v[j] = (n < 8) ? W[(size_t)(k0 + j) * INW + NIN + n] : 0.f;
            v4u hi, lo; unsigned* hp = (unsigned*)&hi; unsigned* lp = (unsigned*)&lo;
#pragma unroll
            for (int j = 0; j < 4; ++j) { const unsigned h = pk2(v[2 * j], v[2 * j + 1]); hp[j] = h; lp[j] = pk2(v[2 * j] - bf2f(h & 0xffffu), v[2 * j + 1] - bf2f(h >> 16)); }
            const int w_ = kk >> 5, blk = (kk >> 2) & 7, gq = kk & 3; const size_t o = ((size_t)(w_ * 8 + blk) * 2) * 64 + 16 * gq + n;
            PANF[o] = hi; PANF[o + 64] = lo; } }
    if (PART == 0) {
        float* COS = (float*)(ws + WS_COS); float* SIN = (float*)(ws + WS_SIN);
        for (int idx = blockIdx.x * NTHR + tid; idx < T * 32; idx += gridDim.x * NTHR) {
            const int t = idx >> 5, i = idx & 31;
            const float angf = (float)t * ROPE_INV[i];
            const double x = (double)angf;
            const double q = __builtin_rint(x * 0.63661977236758134308);
            const double r = (x - q * 1.57079632679489655800) - q * 6.12323399573676603587e-17;
            const double r2 = r * r;
            const double sn = r * (1.0 + r2 * (-1.0 / 6 + r2 * (1.0 / 120 + r2 * (-1.0 / 5040 + r2 * (1.0 / 362880 + r2 * (-1.0 / 39916800 + r2 * (1.0 / 6227020800.0)))))));
            const double cs = 1.0 + r2 * (-0.5 + r2 * (1.0 / 24 + r2 * (-1.0 / 720 + r2 * (1.0 / 40320 + r2 * (-1.0 / 3628800 + r2 * (1.0 / 479001600 + r2 * (-1.0 / 87178291200.0)))))));
            const int qi = ((int)q) & 3;
            const double cv = (qi == 0) ? cs : (qi == 1) ? -sn : (qi == 2) ? -cs : sn;
            const double sv = (qi == 0) ? sn : (qi == 1) ? cs : (qi == 2) ? -sn : -cs;
            COS[idx] = (float)cv; SIN[idx] = (float)sv;
        }
    }
    if (PART == 1) { const float* wexp = a.in[I_WEXPERT]; const float* wgrp = a.in[I_WGROUP]; v4u* WCF = (v4u*)(ws + WS_WCH);
        for (int idx = gw * 64 + lane; idx < 80 * 256; idx += NGW * 64) { const int n = idx % 80, kk = idx / 80, k0 = kk * 8; float v[8];
#pragma unroll
            for (int j = 0; j < 8; ++j) v[j] = (n < 64) ? wexp[(size_t)(k0 + j) * 64 + n] : ((n < 72) ? wgrp[(size_t)(k0 + j) * 8 + (n - 64)] : 0.f);
            v4u hi, lo; unsigned* hp = (unsigned*)&hi; unsigned* lp = (unsigned*)&lo;
#pragma unroll
            for (int j = 0; j < 4; ++j) { const unsigned h = pk2(v[2 * j], v[2 * j + 1]); hp[j] = h; lp[j] = pk2(v[2 * j] - bf2f(h & 0xffffu), v[2 * j + 1] - bf2f(h >> 16)); }
            const int w_ = kk >> 5, blk = (kk >> 2) & 7, g = kk & 3, nt = n >> 4, i = n & 15; const size_t o = ((size_t)((w_ * 8 + blk) * 5 + nt) * 2) * 64 + 16 * g + i;
            WCF[o] = hi; WCF[o + 64] = lo; } }
    {
        bf16* WINT = (bf16*)(ws + WS_WINT); bf16* WOUTT = (bf16*)(ws + WS_WOUTT);
        constexpr int N_IN = 32 * 88, N_OUT = 32 * 32, N_IT = PART == 0 ? N_IN : N_OUT;
        const int nwg = NGW / NWAVES, bw = gw / NWAVES, per = (N_IT + nwg - 1) / nwg, lo = bw * per, hi = (lo + per < N_IT) ? lo + per : N_IT;
        for (int r = lo + wave; r < hi; r += NWAVES) {
            if (PART == 0) transpose_item<1>(a.in[I_WIN], INW, D, WINT, 0, scr, r / 88, r % 88, lane);
            else transpose_item<0>(a.in[I_WOUT], D, D, WOUTT, 0, scr, r / 32, r % 32, lane);
        }
    }
}

__device__ __forceinline__ float mod_sum(const float* MODP, const float* b_ada, int n) {
    const f32x4* p = (const f32x4*)(MODP + (size_t)n * 32); f32x4 v[8];
#pragma unroll
    for (int q = 0; q < 8; ++q) v[q] = p[q];
    float s = b_ada[n];
#pragma unroll
    for (int q = 0; q < 8; ++q) { s += v[q].x; s += v[q].y; s += v[q].z; s += v[q].w; }
    return s; }

__device__ __forceinline__ void phase1(const Args& a, LAS unsigned char* lds, int tid, int lane, int wave) {
    unsigned char* ws = a.ws;
    LAS float* lmod = (LAS float*)lds;
    const float* x = a.in[I_X]; const float* g = a.in[I_GPREMIX]; bf16* HN = (bf16*)(ws + WS_HN); float* GATES = (float*)(ws + WS_GATES); const float* bg = a.in[I_BGATES];
    constexpr int HP = 2052;
    LAS float* H2 = (LAS float*)lds;
    const int G = gridDim.x;
    f32x4 va[8], vb[8];
#define P1_LOADX(base_) do { const bool ok_ = (base_) < T; const f32x4* r0_ = (const f32x4*)(x + (size_t)(ok_ ? (base_) + 2 * wave : 0) * D) + lane; const int st_ = ok_ ? 64 : 0, ro_ = ok_ ? D / 4 : 0; \
        _Pragma("unroll") for (int j_ = 0; j_ < 8; ++j_) { va[j_] = r0_[st_ * j_]; vb[j_] = r0_[ro_ + st_ * j_]; } } while (0)
    int base = blockIdx.x * 16;
    P1_LOADX(base);
    {
        const float* bada = a.in[I_BADA]; const f32x4* MODP0 = (const f32x4*)(ws + WS_MODP0); f32x4 pv_[8];
#pragma unroll
        for (int q = 0; q < 8; ++q) pv_[q] = MODP0[tid + q * NTHR];
#pragma unroll
        for (int q = 0; q < 8; ++q) { const int n = tid + q * NTHR; lmod[n] = bada[n] + ((pv_[q].x + pv_[q].y) + (pv_[q].z + pv_[q].w)); }
    }
    __syncthreads();
    f32x4 A1[8], B1[8];
#pragma unroll
    for (int j = 0; j < 8; ++j) { const int k = 4 * lane + 256 * j; const f32x4 gv = *(const f32x4*)(g + k), sh = *(const LAS f32x4*)(lmod + k), sc = *(const LAS f32x4*)(lmod + 2048 + k);
        A1[j] = gv * (sc + 1.0f); B1[j] = sh; }
    __syncthreads();
    const __amdgpu_buffer_rsrc_t rP = __builtin_amdgcn_make_buffer_rsrc((void*)(ws + WS_PAN), (short)0, 8 * 8 * 2 * 64 * 16, 0x00020000);
    const int g4 = lane >> 4, i = lane & 15, wu = __builtin_amdgcn_readfirstlane(wave);
    for (; base < T; base += G * 16) {
        const int r0 = 2 * wave, t0 = base + r0, t1 = t0 + 1;
        {
            float ss0 = 0.f, ss1 = 0.f;
#pragma unroll
            for (int j = 0; j < 8; ++j) { ss0 += (va[j].x * va[j].x + va[j].y * va[j].y) + (va[j].z * va[j].z + va[j].w * va[j].w); ss1 += (vb[j].x * vb[j].x + vb[j].y * vb[j].y) + (vb[j].z * vb[j].z + vb[j].w * vb[j].w); }
            ss0 = wave_sum(ss0); ss1 = wave_sum(ss1);
            const float rs0 = 1.0f / sqrtf(ss0 * (1.0f / D) + EPS), rs1 = 1.0f / sqrtf(ss1 * (1.0f / D) + EPS);
#pragma unroll
            for (int j = 0; j < 8; ++j) { const int k = 4 * lane + 256 * j;
                const f32x4 h0 = (va[j] * rs0) * A1[j] + B1[j], h1 = (vb[j] * rs1) * A1[j] + B1[j];
                *(v2u*)(HN + (size_t)t0 * D + k) = pk4(h0); *(v2u*)(HN + (size_t)t1 * D + k) = pk4(h1);
                *(LAS f32x4*)(H2 + r0 * HP + k) = h0; *(LAS f32x4*)(H2 + (r0 + 1) * HP + k) = h1; }
        }
        v4u bq[16];
#pragma unroll
        for (int f = 0; f < 16; ++f) bq[f] = __builtin_amdgcn_raw_buffer_load_b128(rP, lane * 16, (wu * 16 + f) * 1024, 0);
        P1_LOADX(base + G * 16);
        __syncthreads();
        {
            f32x4 lacc = {0.f, 0.f, 0.f, 0.f};
            const LAS float* ap = H2 + i * HP + 256 * wave + 8 * g4;
#pragma unroll
            for (int blk = 0; blk < 8; ++blk) {
                const f32x4 av0 = *(const LAS f32x4*)(ap + 32 * blk), av1 = *(const LAS f32x4*)(ap + 32 * blk + 4);
                v4u ahi, alo; unsigned* hp = (unsigned*)&ahi; unsigned* lp = (unsigned*)&alo;
                { const unsigned h = pk2(av0.x, av0.y); hp[0] = h; lp[0] = pk2(av0.x - bf2f(h & 0xffffu), av0.y - bf2f(h >> 16)); }
                { const unsigned h = pk2(av0.z, av0.w); hp[1] = h; lp[1] = pk2(av0.z - bf2f(h & 0xffffu), av0.w - bf2f(h >> 16)); }
                { const unsigned h = pk2(av1.x, av1.y); hp[2] = h; lp[2] = pk2(av1.x - bf2f(h & 0xffffu), av1.y - bf2f(h >> 16)); }
                { const unsigned h = pk2(av1.z, av1.w); hp[3] = h; lp[3] = pk2(av1.z - bf2f(h & 0xffffu), av1.w - bf2f(h >> 16)); }
                const bf16x8 fah = __builtin_bit_cast(bf16x8, ahi), fal = __builtin_bit_cast(bf16x8, alo);
                const bf16x8 fbh = __builtin_bit_cast(bf16x8, bq[2 * blk]), fbl = __builtin_bit_cast(bf16x8, bq[2 * blk + 1]);
                lacc = MFMA16(fal, fbh, lacc); lacc = MFMA16(fah, fbl, lacc); lacc = MFMA16(fah, fbh, lacc);
            }
            __syncthreads();
            LAS float* PART = H2 + wave * 256;
#pragma unroll
            for (int r = 0; r < 4; ++r) PART[(4 * g4 + r) * 16 + i] = lacc[r];
            __syncthreads();
            if (tid < 128) { const int row = tid >> 3, o = tid & 7; float s = 0.f;
#pragma unroll
                for (int w = 0; w < 8; ++w) s += H2[w * 256 + row * 16 + o];
                GATES[(size_t)(base + row) * 8 + o] = s + bg[o]; }
        }
        __syncthreads();
    }
#undef P1_LOADX
}

struct EpiIn {
    static constexpr bool PERM = false, AFTER_DRAIN = false;
    bf16 *Qa, *Ka, *Va, *MQ0, *MK0, *MV, *MO; const float *COS, *SIN;
    __device__ __forceinline__ void operator()(const pg8::f32x4 (&acc)[2][2][4][2], const pg8::Unit& u, int wr, int wc, int fr, int fq) const {
        const int pn = u.pn;
        if (pn < 5) {
            const int L0 = 16 * (wc & 1) + 4 * fq;
#pragma unroll
            for (int ai = 0; ai < 2; ++ai)
#pragma unroll
                for (int m = 0; m < 4; ++m) {
                    const int row = u.pm * 256 + ai * 128 + wr * 64 + m * 16 + fr;
                    const f32x4 c = *(const f32x4*)(COS + (size_t)row * 32 + L0), s = *(const f32x4*)(SIN + (size_t)row * 32 + L0);
#pragma unroll
                    for (int bj = 0; bj < 2; ++bj) {
                        const int hh = 2 * bj + (wc >> 1);
                        const f32x4 t1 = acc[ai][bj][m][0], t2 = acc[ai][bj][m][1];
                        f32x4 o1 = t1 * c - t2 * s, o2 = t2 * c + t1 * s;
                        bf16* dst;
                        if (pn < 4) { o1 = o1 * 0.125f; o2 = o2 * 0.125f; dst = Qa + (size_t)row * NQW + (pn * 4 + hh) * 64; }
                        else dst = Ka + (size_t)row * NKVW + hh * 64;
                        *(v2u*)(dst + L0) = pk4(o1); *(v2u*)(dst + 32 + L0) = pk4(o2);
                    }
                }
        } else {
            bf16* base; int ld, cb;
            if (pn == 5) { base = Va; ld = NKVW; cb = 0; }
            else if (pn < 10) { base = MQ0; ld = MW; cb = (pn - 6) * 256; }
            else if (pn < 14) { base = MK0; ld = MW; cb = (pn - 10) * 256; }
            else if (pn < 18) { base = MV; ld = MW; cb = (pn - 14) * 256; }
            else { base = MO; ld = MW; cb = (pn - 18) * 256; }
#pragma unroll
            for (int ai = 0; ai < 2; ++ai)
#pragma unroll
                for (int m = 0; m < 4; ++m) {
                    const int row = u.pm * 256 + ai * 128 + wr * 64 + m * 16 + fr;
                    bf16* rp = base + (size_t)row * ld + cb + 32 * wc + 4 * fq;
#pragma unroll
                    for (int bj = 0; bj < 2; ++bj)
#pragma unroll
                        for (int n = 0; n < 2; ++n) *(v2u*)(rp + 128 * bj + 16 * n) = pk4(acc[ai][bj][m][n]);
                }
        }
    }
};

__device__ __forceinline__ void attn_phase(const Args& a, LAS unsigned char* lds, int tid, int lane, int wave) {
    unsigned char* ws = a.ws;
    const bf16* Qa = (const bf16*)(ws + WS_QA); const bf16* Ka = (const bf16*)(ws + WS_KA); const bf16* Va = (const bf16*)(ws + WS_VA); bf16* YMIX = (bf16*)(ws + WS_YMIX);
    LAS unsigned char* Kimg = lds; LAS unsigned char* Vimg = lds + 192 * 144;
    const int g = lane >> 4, i = lane & 15, q4 = (lane >> 2) & 3, p4 = lane & 3;
    const int G = gridDim.x;
    v4u kvr[3], vvr[3]; bf16x8 qn[2][2];
#define ATT_LOAD(it_) do { const int qb_ = (it_) >> 2, kvh_ = (it_) & 3, kb_ = qb_ * 64 - 128; \
        _Pragma("unroll") for (int u_ = 0; u_ < 3; ++u_) { const int idx_ = tid + u_ * NTHR, r_ = idx_ >> 3, ch_ = idx_ & 7, t_ = kb_ + r_; kvr[u_] = (v4u){0u, 0u, 0u, 0u}; vvr[u_] = (v4u){0u, 0u, 0u, 0u}; \
            if (t_ >= 0) { kvr[u_] = *(const v4u*)(Ka + (size_t)t_ * NKVW + kvh_ * 64 + ch_ * 8); vvr[u_] = *(const v4u*)(Va + (size_t)t_ * NKVW + kvh_ * 64 + ch_ * 8); } } \
        { const int head_ = kvh_ * 4 + (wave >> 1), qw_ = qb_ * 64 + 32 * (wave & 1); \
          _Pragma("unroll") for (int qt_ = 0; qt_ < 2; ++qt_) _Pragma("unroll") for (int ks_ = 0; ks_ < 2; ++ks_) qn[qt_][ks_] = *(const bf16x8*)(Qa + (size_t)(qw_ + 16 * qt_ + i) * NQW + head_ * 64 + 32 * ks_ + 8 * g); } } while (0)
    int it = blockIdx.x;
    if (it < 128 * 4) ATT_LOAD(it);
    for (; it < 128 * 4; it += G) {
        const int qb = it >> 2, kvh = it & 3;
        const int q0 = qb * 64, kbase = q0 - 128;
#pragma unroll
        for (int u = 0; u < 3; ++u) { const int idx = tid + u * NTHR, r = idx >> 3, ch = idx & 7; *(LAS v4u*)(Kimg + r * 144 + ch * 16) = kvr[u]; *(LAS v4u*)(Vimg + r * 144 + ch * 16) = vvr[u]; }
        bf16x8 qf[2][2];
#pragma unroll
        for (int qt = 0; qt < 2; ++qt)
#pragma unroll
            for (int ks = 0; ks < 2; ++ks) qf[qt][ks] = qn[qt][ks];
        __syncthreads();
        if (it + G < 128 * 4) ATT_LOAD(it + G);
        const int wq = wave & 1, head = kvh * 4 + (wave >> 1), qw0 = q0 + 32 * wq;
        LAS unsigned char* Kw = Kimg + 32 * wq * 144; LAS unsigned char* Vw = Vimg + 32 * wq * 144;
        const int kpl = kbase + 32 * wq + 4 * g;
        f32x4 sacc[10][2];
#pragma unroll
        for (int kt = 0; kt < 10; ++kt) { sacc[kt][0] = (f32x4){0.f, 0.f, 0.f, 0.f}; sacc[kt][1] = (f32x4){0.f, 0.f, 0.f, 0.f}; }
#pragma unroll
        for (int kt = 0; kt < 10; ++kt)
#pragma unroll
            for (int ks = 0; ks < 2; ++ks) { const bf16x8 kf = *(const LAS bf16x8*)(Kw + (16 * kt + i) * 144 + (32 * ks + 8 * g) * 2);
                if (kt <= 8) sacc[kt][0] = MFMA16(kf, qf[0][ks], sacc[kt][0]);
                if (kt >= 1) sacc[kt][1] = MFMA16(kf, qf[1][ks], sacc[kt][1]); }
        const float sink = a.in[I_SINKS][head];
        float linv[2];
#pragma unroll
        for (int qt = 0; qt < 2; ++qt) {
            float mx = sink;
#pragma unroll
            for (int kt = qt; kt <= qt + 8; ++kt)
#pragma unroll
                for (int r = 0; r < 4; ++r) { bool valid = (kpl + 16 * kt + r) >= 0;
                    if (kt == qt) valid = valid && (i < 4 * g + r);
                    if (kt == qt + 8) valid = valid && (i >= 4 * g + r);
                    const float s = valid ? sacc[kt][qt][r] : -INFINITY; sacc[kt][qt][r] = s; mx = fmaxf(mx, s); }
            mx = fmaxf(mx, __shfl_xor(mx, 16)); mx = fmaxf(mx, __shfl_xor(mx, 32));
            float l = 0.f;
#pragma unroll
            for (int kt = qt; kt <= qt + 8; ++kt)
#pragma unroll
                for (int r = 0; r < 4; ++r) { const float p = __expf(sacc[kt][qt][r] - mx); sacc[kt][qt][r] = p; l += p; }
            l += __shfl_xor(l, 16); l += __shfl_xor(l, 32);
            l += __expf(sink - mx);
            linv[qt] = 1.0f / l;
        }
        f32x4 oacc[4][2];
#pragma unroll
        for (int dt = 0; dt < 4; ++dt) { oacc[dt][0] = (f32x4){0.f, 0.f, 0.f, 0.f}; oacc[dt][1] = (f32x4){0.f, 0.f, 0.f, 0.f}; }
#pragma unroll
        for (int u = 0; u < 5; ++u) {
            const bf16x8 pf0 = pack8(sacc[2 * u][0], sacc[2 * u + 1][0]), pf1 = pack8(sacc[2 * u][1], sacc[2 * u + 1][1]);
#pragma unroll
            for (int dt = 0; dt < 4; ++dt) {
                const s16x4 a1 = tr16(Vw + (32 * u + 4 * g + q4) * 144 + (16 * dt + 4 * p4) * 2);
                const s16x4 a2 = tr16(Vw + (32 * u + 16 + 4 * g + q4) * 144 + (16 * dt + 4 * p4) * 2);
                const bf16x8 vf = cat8(a1, a2);
                oacc[dt][0] = MFMA16(vf, pf0, oacc[dt][0]); oacc[dt][1] = MFMA16(vf, pf1, oacc[dt][1]);
            }
        }
#pragma unroll
        for (int qt = 0; qt < 2; ++qt)
#pragma unroll
            for (int dt = 0; dt < 4; ++dt) { const f32x4 o = oacc[dt][qt] * linv[qt];
                *(v2u*)(YMIX + (size_t)(qw0 + 16 * qt + i) * D + head * 64 + 16 * dt + 4 * g) = pk4(o); }
        __syncthreads();
    }
#undef ATT_LOAD
}

__device__ __forceinline__ void modf_phase(const Args& a, int tid, int bw, int nbw) {
    unsigned char* ws = a.ws;
    { const float* MODP = (const float*)(ws + WS_MODP); float* MODF = (float*)(ws + WS_MODF);
      for (int n = 5 * 2048 + bw * NTHR + tid; n < 12288; n += nbw * NTHR) MODF[n] = mod_sum(MODP, a.in[I_BADA], n);
      float* ABC = (float*)(ws + WS_ABC); const float* gpm = a.in[I_GPOSTMIX]; const float* gpf = a.in[I_GPREFFN];
      for (int n = bw * NTHR + tid; n < 2048; n += nbw * NTHR) { const float g1 = mod_sum(MODP, a.in[I_BADA], 2 * 2048 + n), s2 = mod_sum(MODP, a.in[I_BADA], 3 * 2048 + n), c2 = mod_sum(MODP, a.in[I_BADA], 4 * 2048 + n);
          ABC[n] = g1 * gpm[n]; ABC[2048 + n] = gpf[n] * (c2 + 1.0f); ABC[4096 + n] = s2; } }
}
__device__ __forceinline__ void conv_phase(const Args& a, int tid) {
    unsigned char* ws = a.ws;
    const bf16* MQ0 = (const bf16*)(ws + WS_MQ0); const bf16* MK0 = (const bf16*)(ws + WS_MK0); bf16* MQ = (bf16*)(ws + WS_MQ); bf16* MK = (bf16*)(ws + WS_MK);
    const float* cw = a.in[I_CONVW]; const float* cb = a.in[I_CONVB];
    for (int idx = blockIdx.x * NTHR + tid; idx < (T / 16) * 256; idx += gridDim.x * NTHR) {
        const int cc = (idx & 255) * 8, t0 = (idx >> 8) * 16;
        const bf16* src; bf16* dst; float scale; int c0;
        if (cc < 1024) { src = MQ0; dst = MQ; c0 = cc; scale = 1.0f; } else { src = MK0; dst = MK; c0 = cc - 1024; scale = 0.0625f; }
        v4u xs[19];
#pragma unroll
        for (int r = 0; r < 19; ++r) { const int tt = t0 - 3 + r; xs[r] = (v4u){0u, 0u, 0u, 0u}; if (tt >= 0) xs[r] = *(const v4u*)(src + (size_t)tt * MW + c0); }
        float w[4][8], bb[8];
#pragma unroll
        for (int j = 0; j < 4; ++j) { const f32x4 w0 = *(const f32x4*)(cw + j * 2048 + cc), w1 = *(const f32x4*)(cw + j * 2048 + cc + 4);
            w[j][0] = w0.x; w[j][1] = w0.y; w[j][2] = w0.z; w[j][3] = w0.w; w[j][4] = w1.x; w[j][5] = w1.y; w[j][6] = w1.z; w[j][7] = w1.w; }
        { const f32x4 b0 = *(const f32x4*)(cb + cc), b1 = *(const f32x4*)(cb + cc + 4); bb[0] = b0.x; bb[1] = b0.y; bb[2] = b0.z; bb[3] = b0.w; bb[4] = b1.x; bb[5] = b1.y; bb[6] = b1.z; bb[7] = b1.w; }
#pragma unroll
        for (int r = 0; r < 16; ++r) {
            float y[8];
#pragma unroll
            for (int e = 0; e < 8; ++e) y[e] = bb[e];
#pragma unroll
            for (int j = 0; j < 4; ++j) { const v4u xv = xs[r + j];
                y[0] += bf2f(xv.x & 0xffffu) * w[j][0]; y[1] += bf2f(xv.x >> 16) * w[j][1]; y[2] += bf2f(xv.y & 0xffffu) * w[j][2]; y[3] += bf2f(xv.y >> 16) * w[j][3];
                y[4] += bf2f(xv.z & 0xffffu) * w[j][4]; y[5] += bf2f(xv.z >> 16) * w[j][5]; y[6] += bf2f(xv.w & 0xffffu) * w[j][6]; y[7] += bf2f(xv.w >> 16) * w[j][7]; }
            v4u o; o.x = pk2(siluf(y[0]) * scale, siluf(y[1]) * scale); o.y = pk2(siluf(y[2]) * scale, siluf(y[3]) * scale); o.z = pk2(siluf(y[4]) * scale, siluf(y[5]) * scale); o.w = pk2(siluf(y[6]) * scale, siluf(y[7]) * scale);
            *(v4u*)(dst + (size_t)(t0 + r) * MW + c0) = o;
        }
    }
}

constexpr int NSEG = 21;
__device__ __forceinline__ int seg_begin(int g) { return g < 9 ? 7 * g : (g < 15 ? 63 + 6 * (g - 9) : (g < 20 ? 99 + 5 * (g - 15) : 124 + 4 * (g - 20))); }
static_assert(124 + 4 * (21 - 20) == 128, "segments cover the 128 chunks");
__device__ __forceinline__ void gate_prep(const Args& a, LAS unsigned char* lds, int hh, int tid, int lane, int wave) {
    unsigned char* ws = a.ws;
    const float* GATES = (const float*)(ws + WS_GATES);
    float* GA = (float*)(ws + WS_GA) + (size_t)hh * T; float* GB = (float*)(ws + WS_GB) + (size_t)hh * T; float* GM = (float*)(ws + WS_GM) + (size_t)hh * T;
    float* CSG = (float*)(ws + WS_CS) + hh * 128; float* CSM = (float*)(ws + WS_CS) + 512 + hh * 128;
    LAS float* Lb = (LAS float*)lds;
    LAS float* Lm = Lb + 128;
    LAS float* Ls = Lb + 256;
    float bb[16], be[16], pm[16];
#pragma unroll
    for (int cc = 0; cc < 16; ++cc) {
        const int c = wave + 8 * cc, t = c * 64 + lane;
        const float ig = GATES[(size_t)t * 8 + hh], fg = GATES[(size_t)t * 8 + 4 + hh];
        const float logf = fminf(fg, 0.f) - log1pf(__expf(-fabsf(fg)));
        float b = logf;
#pragma unroll
        for (int o = 1; o < 64; o <<= 1) { const float u = __shfl_up(b, o); if (lane >= o) b += u; }
        const float blast = __shfl(b, 63);
        const float beta = ig - b;
        float p = beta;
#pragma unroll
        for (int o = 1; o < 64; o <<= 1) { const float u = __shfl_up(p, o); if (lane >= o) p = fmaxf(p, u); }
        const float mloc = blast + __shfl(p, 63);
        if (lane == 0) { Lb[c] = blast; Lm[c] = mloc; }
        bb[cc] = b; be[cc] = beta; pm[cc] = p;
    }
    __syncthreads();
    if (tid == 0) { float m = 0.f; Ls[0] = 0.f; for (int c = 0; c < 128; ++c) { m = fmaxf(Lb[c] + m, Lm[c]); Ls[c + 1] = m; } }
    __syncthreads();
#pragma unroll
    for (int cc = 0; cc < 16; ++cc) {
        const int c = wave + 8 * cc, t = c * 64 + lane;
        const float m = Ls[c];
        const float mx = fmaxf(m, pm[cc]);
        GA[t] = -mx; GB[t] = be[cc]; GM[t] = bb[cc] + mx;
        if (lane == 0) { CSG[c] = Lb[c] - Ls[c + 1]; CSM[c] = m; }
    }
    if (tid < NSEG) { float s = 0.f; for (int c = seg_begin(tid); c < seg_begin(tid + 1); ++c) { const float csg = Lb[c] - Ls[c + 1]; s += csg + Ls[c]; } ((float*)(ws + WS_CS) + 1024 + hh * 32)[tid] = s; }
    __syncthreads();
}
constexpr int MC_KP = 544;
constexpr int MC_Q = 0, MC_K = 33792, MC_V = MC_K + 64 * MC_KP, MC_VW = MC_V + 17408, MC_SW = MC_VW + 17408, MC_SC = MC_SW + 9216;
constexpr size_t WS_LB = WS_Y;
template <bool SO, bool den_item>
__device__ __forceinline__ void mlstm_item(const Args& a, LAS unsigned char* lds, int hh, int eh, int seg, int tid, int lane, int wave) {
    unsigned char* ws = a.ws;
    const bf16* MQ = (const bf16*)(ws + WS_MQ); const bf16* MK = (const bf16*)(ws + WS_MK); const bf16* MV = (const bf16*)(ws + WS_MV);
    const float* GA = (const float*)(ws + WS_GA) + (size_t)hh * T; const float* GB = (const float*)(ws + WS_GB) + (size_t)hh * T;
    const float* CSG = (const float*)(ws + WS_CS) + hh * 128; const float* CSM = (const float*)(ws + WS_CS) + 512 + hh * 128;
    float* NUM = (float*)(ws + WS_NUM); float* DEN = (float*)(ws + WS_DEN) + (size_t)hh * T;
    const int g = lane >> 4, i = lane & 15, q4 = (lane >> 2) & 3, p4 = lane & 3, et = wave;
    LAS unsigned char* Qi = lds + MC_Q; LAS unsigned char* Ki = lds + MC_K; LAS unsigned char* Vi = lds + MC_V; LAS unsigned char* Vw = lds + MC_VW; LAS unsigned char* Sw = lds + MC_SW;
    LAS float* SC = (LAS float*)(lds + MC_SC);
    const int kcb0 = 16 * g + 128 * ((i >> 3) & 1), kcb1 = 16 * g - 128 * ((i >> 3) & 1);
    const int kub0 = (8 * g + q4) * MC_KP + 8 * p4 + 128 * (g & 1), kub1 = (8 * g + q4) * MC_KP + 8 * p4 - 128 * (g & 1);
    const int c0 = seg_begin(seg), c1 = seg_begin(seg + 1);
    const int cl_ = (c0 + (lane & 7) < 128) ? c0 + (lane & 7) : 127; const float csgv = CSG[cl_], csmv = CSM[cl_];
    const unsigned vonum = (unsigned)((4 * g * MW + i) * 4);
    f32x4 Dst[16];
#pragma unroll
    for (int dt = 0; dt < 16; ++dt) Dst[dt] = (f32x4){0.f, 0.f, 0.f, 0.f};
    if (!SO) {
        const v4u* Lp0 = (const v4u*)(ws + WS_LB) + ((((size_t)(hh * 3 + eh) * NSEG) * 8 + wave) * 8) * 64 + lane;
        v4u Lc[8], Ln[8];
        const float segv = ((const float*)(ws + WS_CS) + 1024 + hh * 32)[lane & 31];
#define MC_FOLD(L_, A_, w_) do { _Pragma("unroll") for (int k_ = 0; k_ < 8; ++k_) { const v4u u_ = L_[k_]; \
            const f32x4 lo_ = {bf2f(u_.x & 0xffffu), bf2f(u_.x >> 16), bf2f(u_.y & 0xffffu), bf2f(u_.y >> 16)}, hi_ = {bf2f(u_.z & 0xffffu), bf2f(u_.z >> 16), bf2f(u_.w & 0xffffu), bf2f(u_.w >> 16)}; \
            Dst[2 * k_] = Dst[2 * k_] * (A_) + lo_ * (w_); Dst[2 * k_ + 1] = Dst[2 * k_ + 1] * (A_) + hi_ * (w_); } } while (0)
        if (seg > 0) {
#pragma unroll
            for (int k = 0; k < 8; ++k) Lc[k] = Lp0[k * 64];
        }
#pragma unroll 1
        for (int gp = 0; gp < seg; gp += 2) {
            const bool ok1 = gp + 1 < seg; const int g1 = ok1 ? gp + 1 : gp, g2 = (gp + 2 < seg) ? gp + 2 : g1;
            { const v4u* Lg = Lp0 + (size_t)g1 * (8 * 8 * 64);
#pragma unroll
              for (int k = 0; k < 8; ++k) Ln[k] = Lg[k * 64]; }
            { const float A = __expf(__int_as_float(__builtin_amdgcn_readlane(__float_as_int(segv), gp))); MC_FOLD(Lc, A, 1.0f); }
            { const v4u* Lg = Lp0 + (size_t)g2 * (8 * 8 * 64);
#pragma unroll
              for (int k = 0; k < 8; ++k) Lc[k] = Lg[k * 64]; }
            { const float e1 = __expf(__int_as_float(__builtin_amdgcn_readlane(__float_as_int(segv), g1))); const float A = ok1 ? e1 : 1.0f, w = ok1 ? 1.0f : 0.0f; MC_FOLD(Ln, A, w); }
        }
#undef MC_FOLD
    }
    v4u pq[4], pk[4], pv[2]; float pgb[2], pal = 0.f, pbe = 0.f;
    const char* MQu = (const char*)(MQ + hh * 256); const char* MKu = (const char*)(MK + hh * 256); const char* MVu = (const char*)(MV + hh * 256 + (den_item ? 0 : eh * 128));
    const unsigned voqk = (unsigned)(((tid >> 5) * MW + (tid & 31) * 8) * 2), vov = (unsigned)(((tid >> 4) * MW + (tid & 15) * 8) * 2), vogb = (unsigned)((tid >> 4) * 4);
#define MC_ISSUE(c_) do { const size_t tb_ = (size_t)(c_) * 64 * MW * 2; \
        _Pragma("unroll") for (int j_ = 0; j_ < 4; ++j_) pk[j_] = *(const v4u*)(MKu + (tb_ + (size_t)j_ * 16 * MW * 2) + voqk); \
        _Pragma("unroll") for (int j_ = 0; j_ < 2; ++j_) { pgb[j_] = *(const float*)((const char*)(GB + (c_) * 64 + j_ * 32) + vogb); \
            if (!den_item) pv[j_] = *(const v4u*)(MVu + (tb_ + (size_t)j_ * 32 * MW * 2) + vov); } \
        if (!SO && tid < 64) { pal = GA[(c_) * 64 + tid]; pbe = GB[(c_) * 64 + tid]; } } while (0)
#define MC_ISSUE_Q(c_) do { const size_t tb_ = (size_t)(c_) * 64 * MW * 2; \
        _Pragma("unroll") for (int j_ = 0; j_ < 4; ++j_) pq[j_] = *(const v4u*)(MQu + (tb_ + (size_t)j_ * 16 * MW * 2) + voqk); } while (0)
#define MC_STORE(c_) do { const float gam_ = __int_as_float(__builtin_amdgcn_readlane(__float_as_int(csgv), (c_) - c0)), mp_ = __int_as_float(__builtin_amdgcn_readlane(__float_as_int(csmv), (c_) - c0)); \
        _Pragma("unroll") for (int j_ = 0; j_ < 4; ++j_) { const int idx_ = tid + j_ * NTHR, r_ = idx_ >> 5, ch_ = idx_ & 31; \
            if (!SO) *(LAS v4u*)(Qi + r_ * 528 + ch_ * 16) = pq[j_]; *(LAS v4u*)(Ki + r_ * MC_KP + ((ch_ * 16) ^ (((r_ >> 3) & 1) << 7))) = pk[j_]; } \
        _Pragma("unroll") for (int j_ = 0; j_ < 2; ++j_) { const int idx_ = tid + j_ * NTHR, r_ = idx_ >> 4, ch_ = idx_ & 15; \
            const float w_ = __expf(pgb[j_] + gam_); v4u vv_, vw_; \
            if (!den_item) { vv_ = pv[j_]; \
                vw_.x = pk2(bf2f(vv_.x & 0xffffu) * w_, bf2f(vv_.x >> 16) * w_); vw_.y = pk2(bf2f(vv_.y & 0xffffu) * w_, bf2f(vv_.y >> 16) * w_); \
                vw_.z = pk2(bf2f(vv_.z & 0xffffu) * w_, bf2f(vv_.z >> 16) * w_); vw_.w = pk2(bf2f(vv_.w & 0xffffu) * w_, bf2f(vv_.w >> 16) * w_); \
            } else { vv_ = (v4u){0u, 0u, 0u, 0u}; vw_ = (v4u){0u, 0u, 0u, 0u}; if (ch_ == 0) { vv_.x = 0x3f80u; vw_.x = pk2(w_, 0.f); } } \
            if (!SO) *(LAS v4u*)(Vi + r_ * 272 + ch_ * 16) = vv_; *(LAS v4u*)(Vw + r_ * 272 + ch_ * 16) = vw_; } \
        if (!SO && tid < 64) { SC[tid] = pal; SC[64 + tid] = pbe; SC[192 + tid] = __expf(pal + mp_); } } while (0)
    MC_ISSUE(c0); if (!SO) MC_ISSUE_Q(c0);
    MC_STORE(c0);
    __syncthreads();
    for (int c = c0; c < c1; ++c) {
        const int t0 = c * 64;
        const float a_old = __expf(__int_as_float(__builtin_amdgcn_readlane(__float_as_int(csgv), c - c0)) + __int_as_float(__builtin_amdgcn_readlane(__float_as_int(csmv), c - c0)));
        if (c + 1 < c1) { MC_ISSUE(c + 1); if (!SO) MC_ISSUE_Q(c + 1); }
        if (!SO) {
            f32x4 iacc[4];
            const int lt = wave >> 1;
#pragma unroll
            for (int sti = 0; sti < 2; ++sti) {
                const int st = 2 * (wave & 1) + sti;
                f32x4 acc = {0.f, 0.f, 0.f, 0.f};
#pragma unroll
                for (int ks = 0; ks < 8; ++ks) { const bf16x8 af = *(const LAS bf16x8*)(Qi + (16 * lt + i) * 528 + (32 * ks + 8 * g) * 2);
                    const bf16x8 bf = *(const LAS bf16x8*)(Ki + (16 * st + i) * MC_KP + ((ks & 2) ? kcb1 : kcb0) + 64 * ks); acc = MFMA16(af, bf, acc); }
                const int s = 16 * st + i; const float bs = SC[64 + s];
#pragma unroll
                for (int r = 0; r < 4; ++r) { const int l = 16 * lt + 4 * g + r; const float val = (s <= l) ? acc[r] * __expf(SC[l] + bs) : 0.f;
                    *(LAS unsigned short*)(Sw + l * 144 + s * 2) = (unsigned short)(pk2(val, 0.f) & 0xffffu); }
            }
#pragma unroll
            for (int lt2 = 0; lt2 < 4; ++lt2) iacc[lt2] = (f32x4){0.f, 0.f, 0.f, 0.f};
#pragma unroll
            for (int kb = 0; kb < 8; ++kb) {
                const bf16x8 bfr = pack8(Dst[2 * kb], Dst[2 * kb + 1]);
#pragma unroll
                for (int lt2 = 0; lt2 < 4; ++lt2) {
                    const v2u lo = *(const LAS v2u*)(Qi + (16 * lt2 + i) * 528 + (32 * kb + 4 * g) * 2), hi = *(const LAS v2u*)(Qi + (16 * lt2 + i) * 528 + (32 * kb + 16 + 4 * g) * 2);
                    v4u av; av.x = lo.x; av.y = lo.y; av.z = hi.x; av.w = hi.y;
                    iacc[lt2] = MFMA16(__builtin_bit_cast(bf16x8, av), bfr, iacc[lt2]);
                }
            }
#pragma unroll
            for (int lt2 = 0; lt2 < 4; ++lt2)
#pragma unroll
                for (int r = 0; r < 4; ++r) iacc[lt2][r] *= SC[192 + 16 * lt2 + 4 * g + r];
            __syncthreads();
#pragma unroll
            for (int ks2 = 0; ks2 < 2; ++ks2) {
                const bf16x8 bfr = cat8(tr16(Vi + (32 * ks2 + 8 * g + q4) * 272 + (16 * et + 4 * p4) * 2), tr16(Vi + (32 * ks2 + 8 * g + 4 + q4) * 272 + (16 * et + 4 * p4) * 2));
#pragma unroll
                for (int lt2 = 0; lt2 < 4; ++lt2) { const bf16x8 afr = *(const LAS bf16x8*)(Sw + (16 * lt2 + i) * 144 + (32 * ks2 + 8 * g) * 2); iacc[lt2] = MFMA16(afr, bfr, iacc[lt2]); }
            }
#pragma unroll
            for (int lt2 = 0; lt2 < 4; ++lt2)
#pragma unroll
                for (int r = 0; r < 4; ++r) { const float o = iacc[lt2][r];
                    if (!den_item) *(float*)((char*)(NUM + (size_t)(t0 + 16 * lt2 + r) * MW + hh * 256 + eh * 128 + 16 * et) + vonum) = o;
                    else if (wave == 0 && i == 0) DEN[t0 + 16 * lt2 + 4 * g + r] = o; }
        }
#pragma unroll
        for (int dt = 0; dt < 16; ++dt) Dst[dt] = Dst[dt] * a_old;
#pragma unroll
        for (int ks2 = 0; ks2 < 2; ++ks2) {
            const bf16x8 bfr = cat8(tr16(Vw + (32 * ks2 + 8 * g + q4) * 272 + (16 * et + 4 * p4) * 2), tr16(Vw + (32 * ks2 + 8 * g + 4 + q4) * 272 + (16 * et + 4 * p4) * 2));
#pragma unroll
            for (int dt = 0; dt < 16; ++dt) {
                const bf16x8 afr = cat8(tr16(Ki + (32 * ks2) * MC_KP + ((dt & 4) ? kub1 : kub0) + 32 * dt), tr16(Ki + (32 * ks2 + 4) * MC_KP + ((dt & 4) ? kub1 : kub0) + 32 * dt));
                Dst[dt] = MFMA16(afr, bfr, Dst[dt]);
            }
        }
        __syncthreads();
        if (c + 1 < c1) { MC_STORE(c + 1); }
        __syncthreads();
    }
#undef MC_ISSUE
#undef MC_ISSUE_Q
#undef MC_STORE
    if (SO) {
        v4u* Lp = (v4u*)(ws + WS_LB) + ((((size_t)(hh * 3 + eh) * NSEG + seg) * 8 + wave) * 8) * 64 + lane;
#pragma unroll
        for (int k = 0; k < 8; ++k) Lp[k * 64] = __builtin_bit_cast(v4u, pack8(Dst[2 * k], Dst[2 * k + 1]));
    }
}

__device__ __forceinline__ void mlstm_norm_phase(const Args& a, int lane, int wave) {
    unsigned char* ws = a.ws;
    const float* NUM = (const float*)(ws + WS_NUM); const float* DEN = (const float*)(ws + WS_DEN); const float* GM = (const float*)(ws + WS_GM);
    const bf16* MO = (const bf16*)(ws + WS_MO); bf16* YMIX = (bf16*)(ws + WS_YMIX); const float* mn = a.in[I_MNORM];
    const int gw = blockIdx.x * NWAVES + wave, NGW = gridDim.x * NWAVES;
    f32x4 nva, nvb; float dena, denb, mta, mtb; v2u moa, mob;
#define P5_LOAD(nv_, den_, mt_, mo_, it_) do { const int t_ = (it_) >> 2, hh_ = (it_) & 3; nv_ = *(const f32x4*)(NUM + (size_t)t_ * MW + hh_ * 256 + 4 * lane); \
        den_ = DEN[(size_t)hh_ * T + t_]; mt_ = GM[(size_t)hh_ * T + t_]; mo_ = *(const v2u*)(MO + (size_t)t_ * MW + hh_ * 256 + 4 * lane); } while (0)
#define P5_ITEM(nv_, den_, mt_, mo_, it_) do { const int t_ = (it_) >> 2, hh_ = (it_) & 3; \
        const float dd_ = fmaxf(fabsf(den_), __expf(-mt_)); const f32x4 h_ = nv_ / dd_; \
        const float ss_ = wave_sum((h_.x * h_.x + h_.y * h_.y) + (h_.z * h_.z + h_.w * h_.w)); const float r_ = 1.0f / sqrtf(ss_ * (1.0f / 256.0f) + EPS); \
        const f32x4 mv_ = *(const f32x4*)(mn + hh_ * 256 + 4 * lane); f32x4 y_; \
        y_.x = sigmoidf_(bf2f(mo_.x & 0xffffu)) * (h_.x * r_ * mv_.x); y_.y = sigmoidf_(bf2f(mo_.x >> 16)) * (h_.y * r_ * mv_.y); \
        y_.z = sigmoidf_(bf2f(mo_.y & 0xffffu)) * (h_.z * r_ * mv_.z); y_.w = sigmoidf_(bf2f(mo_.y >> 16)) * (h_.w * r_ * mv_.w); \
        *(v2u*)(YMIX + (size_t)t_ * D + 1024 + hh_ * 256 + 4 * lane) = pk4(y_); } while (0)
    int it = gw; const int NIT = T * 4;
    if (it < NIT) P5_LOAD(nva, dena, mta, moa, it);
    for (; it < NIT; it += 2 * NGW) {
        const int i2 = it + NGW, i3 = it + 2 * NGW;
        if (i2 < NIT) P5_LOAD(nvb, denb, mtb, mob, i2);
        P5_ITEM(nva, dena, mta, moa, it);
        if (i2 < NIT) { if (i3 < NIT) P5_LOAD(nva, dena, mta, moa, i3); P5_ITEM(nvb, denb, mtb, mob, i2); }
    }
#undef P5_LOAD
#undef P5_ITEM
}

struct EpiY {
    static constexpr bool PERM = false, AFTER_DRAIN = false;
    float* Y;
    __device__ __forceinline__ void operator()(const pg8::f32x4 (&acc)[2][2][4][2], const pg8::Unit& u, int wr, int wc, int fr, int fq) const {
#pragma unroll
        for (int ai = 0; ai < 2; ++ai)
#pragma unroll
            for (int m = 0; m < 4; ++m) {
                const int row = u.pm * 256 + ai * 128 + wr * 64 + m * 16 + fr;
                float* rp = Y + (size_t)row * D + u.pn * 256 + 32 * wc + 4 * fq;
#pragma unroll
                for (int bj = 0; bj < 2; ++bj)
#pragma unroll
                    for (int n = 0; n < 2; ++n) *(f32x4*)(rp + 128 * bj + 16 * n) = acc[ai][bj][m][n];
            }
    }
};

__device__ __forceinline__ void phase7(const Args& a, LAS unsigned char* lds, int tid, int lane, int wave) {
    unsigned char* ws = a.ws;
    const float* Y = (const float*)(ws + WS_Y); bf16* X1 = (bf16*)(ws + WS_X1); bf16* HN = (bf16*)(ws + WS_HN);
    float* RW = (float*)(ws + WS_ROUTE + 65536);
    LAS int* rex = (LAS int*)(lds + 137216);
    int npass = 0;
    const float* x = a.in[I_X]; const float* bexp = a.in[I_BEXPERT]; const float* bgrp = a.in[I_BGROUP];
    constexpr int HP = 2052;
    LAS float* H2 = (LAS float*)lds;
    LAS float* LG = (LAS float*)(lds + 131584);
    const float* ABC = (const float*)(ws + WS_ABC);
    const __amdgpu_buffer_rsrc_t rW = __builtin_amdgcn_make_buffer_rsrc((void*)(ws + WS_WCH), (short)0, 80 * 2048 * 4, 0x00020000);
    for (int base = blockIdx.x * 16; base < T; base += gridDim.x * 16) {
        {
            const int r0 = 2 * wave, t0 = base + r0, t1 = t0 + 1;
            const f32x4* y0p = (const f32x4*)(Y + (size_t)t0 * D) + lane; const f32x4* y1p = (const f32x4*)(Y + (size_t)t1 * D) + lane;
            const f32x4* x0p = (const f32x4*)(x + (size_t)t0 * D) + lane; const f32x4* x1p = (const f32x4*)(x + (size_t)t1 * D) + lane;
            f32x4 v0[8], v1[8], xa[8], xb[8]; float ss0 = 0.f, ss1 = 0.f;
#pragma unroll
            for (int j = 0; j < 8; ++j) { v0[j] = y0p[64 * j]; v1[j] = y1p[64 * j]; }
#pragma unroll
            for (int j = 0; j < 8; ++j) { xa[j] = x0p[64 * j]; xb[j] = x1p[64 * j]; }
#pragma unroll
            for (int j = 0; j < 8; ++j) { ss0 += (v0[j].x * v0[j].x + v0[j].y * v0[j].y) + (v0[j].z * v0[j].z + v0[j].w * v0[j].w); ss1 += (v1[j].x * v1[j].x + v1[j].y * v1[j].y) + (v1[j].z * v1[j].z + v1[j].w * v1[j].w); }
            ss0 = wave_sum(ss0); ss1 = wave_sum(ss1);
            const float rs0 = 1.0f / sqrtf(ss0 * (1.0f / D) + EPS), rs1 = 1.0f / sqrtf(ss1 * (1.0f / D) + EPS);
            float q0 = 0.f, q1 = 0.f;
#pragma unroll
            for (int j = 0; j < 8; ++j) { const int k = 4 * lane + 256 * j; const f32x4 A = *(const f32x4*)(ABC + k);
                const f32x4 a0 = xa[j] + A * (v0[j] * rs0), a1 = xb[j] + A * (v1[j] * rs1);
                *(v2u*)(X1 + (size_t)t0 * D + k) = pk4(a0); *(v2u*)(X1 + (size_t)t1 * D + k) = pk4(a1); v0[j] = a0; v1[j] = a1;
                q0 += (a0.x * a0.x + a0.y * a0.y) + (a0.z * a0.z + a0.w * a0.w); q1 += (a1.x * a1.x + a1.y * a1.y) + (a1.z * a1.z + a1.w * a1.w); }
            q0 = wave_sum(q0); q1 = wave_sum(q1);
            const float rt0 = 1.0f / sqrtf(q0 * (1.0f / D) + EPS), rt1 = 1.0f / sqrtf(q1 * (1.0f / D) + EPS);
#pragma unroll
            for (int j = 0; j < 8; ++j) { const int k = 4 * lane + 256 * j; const f32x4 B = *(const f32x4*)(ABC + 2048 + k), C = *(const f32x4*)(ABC + 4096 + k);
                const f32x4 h0 = (v0[j] * rt0) * B + C, h1 = (v1[j] * rt1) * B + C;
                *(v2u*)(HN + (size_t)t0 * D + k) = pk4(h0); *(v2u*)(HN + (size_t)t1 * D + k) = pk4(h1);
                *(LAS f32x4*)(H2 + r0 * HP + k) = h0; *(LAS f32x4*)(H2 + (r0 + 1) * HP + k) = h1; }
        }
        __syncthreads();
        {
            const int g = lane >> 4, i = lane & 15;
            f32x4 lacc[5];
#pragma unroll
            for (int nt = 0; nt < 5; ++nt) lacc[nt] = (f32x4){0.f, 0.f, 0.f, 0.f};
            const LAS float* ap = H2 + i * HP + 256 * wave + 8 * g;
            const int wu = __builtin_amdgcn_readfirstlane(wave);
            v4u bq0[10], bq1[10];
#define LG_LOAD(set_, blk_) do { _Pragma("unroll") for (int f_ = 0; f_ < 10; ++f_) set_[f_] = __builtin_amdgcn_raw_buffer_load_b128(rW, lane * 16, ((wu * 8 + (blk_)) * 10 + f_) * 1024, 0); } while (0)
#define LG_STEP(set_, blk_) do { const f32x4 av0 = *(const LAS f32x4*)(ap + 32 * (blk_)), av1 = *(const LAS f32x4*)(ap + 32 * (blk_) + 4); \
                v4u ahi, alo; unsigned* hp = (unsigned*)&ahi; unsigned* lp = (unsigned*)&alo; \
                { const unsigned h = pk2(av0.x, av0.y); hp[0] = h; lp[0] = pk2(av0.x - bf2f(h & 0xffffu), av0.y - bf2f(h >> 16)); } \
                { const unsigned h = pk2(av0.z, av0.w); hp[1] = h; lp[1] = pk2(av0.z - bf2f(h & 0xffffu), av0.w - bf2f(h >> 16)); } \
                { const unsigned h = pk2(av1.x, av1.y); hp[2] = h; lp[2] = pk2(av1.x - bf2f(h & 0xffffu), av1.y - bf2f(h >> 16)); } \
                { const unsigned h = pk2(av1.z, av1.w); hp[3] = h; lp[3] = pk2(av1.z - bf2f(h & 0xffffu), av1.w - bf2f(h >> 16)); } \
                const bf16x8 fah = __builtin_bit_cast(bf16x8, ahi), fal = __builtin_bit_cast(bf16x8, alo); \
                _Pragma("unroll") for (int nt = 0; nt < 5; ++nt) { const bf16x8 fbh = __builtin_bit_cast(bf16x8, set_[2 * nt]), fbl = __builtin_bit_cast(bf16x8, set_[2 * nt + 1]); \
                    lacc[nt] = MFMA16(fal, fbh, lacc[nt]); lacc[nt] = MFMA16(fah, fbl, lacc[nt]); lacc[nt] = MFMA16(fah, fbh, lacc[nt]); } } while (0)
            LG_LOAD(bq0, 0);
#pragma unroll
            for (int b2 = 0; b2 < 4; ++b2) {
                LG_LOAD(bq1, 2 * b2 + 1); LG_STEP(bq0, 2 * b2); __builtin_amdgcn_sched_barrier(0);
                if (b2 < 3) LG_LOAD(bq0, 2 * b2 + 2);
                LG_STEP(bq1, 2 * b2 + 1); __builtin_amdgcn_sched_barrier(0);
            }
#undef LG_LOAD
#undef LG_STEP
            __syncthreads();
            LAS float* PART = H2 + wave * (16 * 80);
#pragma unroll
            for (int nt = 0; nt < 5; ++nt)
#pragma unroll
                for (int r = 0; r < 4; ++r) PART[(4 * g + r) * 80 + 16 * nt + i] = lacc[nt][r];
            __syncthreads();
            for (int idx = tid; idx < 16 * 80; idx += NTHR) { float s = 0.f;
#pragma unroll
                for (int w = 0; w < 8; ++w) s += H2[w * (16 * 80) + idx];
                const int n = idx % 80; s += (n < 64) ? bexp[n] : ((n < 72) ? bgrp[n - 64] : 0.f); LG[idx] = s; }
        }
        __syncthreads();
        if (tid < 16) {
            const int r = tid, t = base + r; const LAS float* lg = LG + r * 80;
            int gi = 0; float gm = lg[64];
#pragma unroll
            for (int j = 1; j < 8; ++j) { const float v = lg[64 + j]; if (v > gm) { gm = v; gi = j; } }
            float gs = 0.f;
#pragma unroll
            for (int j = 0; j < 8; ++j) gs += expf(lg[64 + j] - gm);
            const float gprob = 1.0f / gs;
            int i0 = 0; float v0 = lg[gi * 8];
#pragma unroll
            for (int j = 1; j < 8; ++j) { const float v = lg[gi * 8 + j]; if (v > v0) { v0 = v; i0 = j; } }
            int i1 = -1; float v1 = -INFINITY;
#pragma unroll
            for (int j = 0; j < 8; ++j) { const float v = lg[gi * 8 + j]; if (j != i0 && v > v1) { v1 = v; i1 = j; } }
            const float e1 = expf(v1 - v0); const float w0 = gprob / (1.0f + e1), w1 = gprob * e1 / (1.0f + e1);
            const int ex0 = gi * 8 + i0, ex1 = gi * 8 + i1;
            RW[2 * t] = w0; RW[2 * t + 1] = w1;
            rex[(npass * 16 + r) * 2] = ex0; rex[(npass * 16 + r) * 2 + 1] = ex1;
        }
        __syncthreads();
        ++npass;
    }
    {
        const int nasg = npass * 32;
        LAS int* lbase = rex + 2048;
        unsigned* CNT = (unsigned*)(ws + WS_CTL) + CW_CNT; int* LISTS = (int*)(ws + WS_LISTS);
        if (tid < NEXP) { int c = 0; for (int q = 0; q < nasg; ++q) c += (rex[q] == tid) ? 1 : 0;
            lbase[tid] = c ? (int)__hip_atomic_fetch_add(CNT + tid * 32, (unsigned)c, __ATOMIC_RELAXED, __HIP_MEMORY_SCOPE_AGENT) : 0; }
        __syncthreads();
        for (int j = tid; j < nasg; j += NTHR) { const int ej = rex[j]; int rk = 0; for (int q = 0; q < j; ++q) rk += (rex[q] == ej) ? 1 : 0;
            const int pass = j >> 5, r = (j >> 1) & 15, k = j & 1; const int t = ((int)blockIdx.x + pass * (int)gridDim.x) * 16 + r;
            LISTS[(size_t)ej * LCAP + lbase[ej] + rk] = 2 * t + k; }
        __syncthreads();
    }
}

constexpr int XG_RM = 256, XG_AP = 160, XG_BP = 272, XG_ABYTES = XG_RM * XG_AP, XG_BBYTES = 64 * XG_BP, XG_BUF = XG_ABYTES + XG_BBYTES;
static_assert(2 * XG_BUF <= 147456 - 2048, "expert GEMM LDS");
__device__ __forceinline__ int wave_iscan(int v, int lane) {
#pragma unroll
    for (int d = 1; d < 64; d <<= 1) { const int t = __shfl_up(v, d); if (lane >= d) v += t; }
    return v; }
__device__ __forceinline__ void expert_offsets(const unsigned* CNT, LAS int* cnts  , LAS int* offs  , LAS int* eptab  , int rm, int tid) {
    if (tid < NEXP) { const int lane = tid, c = (int)__hip_atomic_load(CNT + tid * 32, RLX_AGENT); const int np = (c + rm - 1) / rm;
        const int ic = wave_iscan(c, lane);
        cnts[lane] = c; offs[lane] = ic - c; if (lane == NEXP - 1) offs[NEXP] = ic;
        const int n2 = (np == 2) ? 2 : 0, n3 = (np >= 3) ? np : 0, n1 = (np == 1) ? 1 : 0;
        const int i2 = wave_iscan(n2, lane), i3 = wave_iscan(n3, lane), i1 = wave_iscan(n1, lane);
        const int t2 = __shfl(i2, 63), t3 = __shfl(i3, 63), t1 = __shfl(i1, 63);
        const int pos = (np == 2) ? (i2 - n2) : (np >= 3) ? (t2 + i3 - n3) : (t2 + t3 + i1 - n1);
        for (int p = 0; p < np; ++p) eptab[pos + p] = lane | (p << 8);
        if (lane == 0) eptab[191] = t2 + t3 + t1; }
    __syncthreads();
}
template <bool UP>
__device__ __forceinline__ void xgemm_unit(const Args& a, LAS unsigned char* lds, int e, int s, int cnt, int off_e, int rp, int tid, int lane, int wave) {
    unsigned char* ws = a.ws;
    constexpr int K = UP ? D : DE, NK = K / 64, LDB = UP ? DE : D;
    const int* LISTS = (const int*)(ws + WS_LISTS) + (size_t)e * LCAP; const float* RW = (const float*)(ws + WS_ROUTE + 65536);
    const bf16* Abase = UP ? (const bf16*)(ws + WS_HN) : (const bf16*)(ws + WS_HG);
    bf16* HG = (bf16*)(ws + WS_HG); bf16* YA = (bf16*)(ws + WS_YA);
    const bool loader = wave < 4;
    const int cw = wave & 3;
    {
        const int nrows = (cnt - rp < XG_RM) ? (cnt - rp) : XG_RM;
        if (loader) {
            const int tl = tid & 255;
            const int arow = tl >> 3, ach = tl & 7;
            const int n4 = UP ? (tl & 15) : (tl & 31), kr = UP ? ((tl >> 4) & 7) : (tl >> 5), bcol = UP ? (64 * ((wave >> 1) & 1) + 4 * n4) : 4 * n4;
            const float* Bu = UP ? ((((wave >> 1) & 1) ? a.in[I_W3] : a.in[I_W1]) + (size_t)e * D * DE) : (a.in[I_W2] + (size_t)e * DE * D);
            const __amdgpu_buffer_rsrc_t rB = __builtin_amdgcn_make_buffer_rsrc((void*)Bu, (short)0, K * LDB * 4, 0x00020000);
            const __amdgpu_buffer_rsrc_t rA = __builtin_amdgcn_make_buffer_rsrc((void*)Abase, (short)0, UP ? T * D * 2 : 2 * T * DE * 2, 0x00020000);
            const unsigned boff = (unsigned)(kr * LDB + 4 * n4 + (UP ? 64 : 128) * s) * 4u;
            const int bdst = XG_ABYTES + kr * XG_BP + bcol * 2;
            unsigned aoff[8];
#pragma unroll
            for (int j = 0; j < 8; ++j) { int rr = arow + 32 * j; rr = (rr < nrows) ? rr : (nrows - 1);
                if (UP) aoff[j] = ((unsigned)(LISTS[rp + rr] >> 1) * (unsigned)D + ach * 8) * 2u; else aoff[j] = ((unsigned)(off_e + rp + rr) * (unsigned)DE + ach * 8) * 2u; }
            f32x4 pb0[8], pb1[8], pb2[8]; v4u pa0[8], pa1[8], pa2[8];
            static_assert(NK % 3 == 2, "loader ring schedule");
#define XG_ISSUE_B(pb_, t_) do { _Pragma("unroll") for (int j_ = 0; j_ < 8; ++j_) pb_[j_] = __builtin_bit_cast(f32x4, __builtin_amdgcn_raw_buffer_load_b128(rB, boff, (64 * (t_) + 8 * j_) * LDB * 4, 0)); } while (0)
#define XG_ISSUE_A(pa_, t_) do { _Pragma("unroll") for (int j_ = 0; j_ < 8; ++j_) pa_[j_] = __builtin_amdgcn_raw_buffer_load_b128(rA, aoff[j_], 128 * (t_), 0); } while (0)
#define XG_STORE(pb_, pa_, bo_) do { _Pragma("unroll") for (int j_ = 0; j_ < 8; ++j_) *(LAS v2u*)(lds + (bo_) + bdst + 8 * j_ * XG_BP) = pk4(pb_[j_]); \
            _Pragma("unroll") for (int j_ = 0; j_ < 8; ++j_) *(LAS v4u*)(lds + (bo_) + (arow + 32 * j_) * XG_AP + ach * 16) = pa_[j_]; } while (0)
#define XG_STEP(t_, PBN, PAN, PBS, PAS) do { XG_ISSUE_A(PAN, (t_) + 2); { const int tb_ = ((t_) + 3 < NK) ? (t_) + 3 : NK - 1; XG_ISSUE_B(PBN, tb_); } \
                XG_STORE(PBS, PAS, (((t_) + 1) & 1) * XG_BUF); __syncthreads(); } while (0)
            __builtin_amdgcn_s_setprio(1);
            int ras_ = 0; float rw_ = 0.f;
            if (!UP) ras_ = LISTS[rp + ((tl < nrows) ? tl : nrows - 1)];
            XG_ISSUE_A(pa0, 0); XG_ISSUE_B(pb0, 0); XG_ISSUE_A(pa1, 1); XG_ISSUE_B(pb1, 1); XG_ISSUE_B(pb2, 2);
            XG_STORE(pb0, pa0, 0);
            __syncthreads();
#pragma unroll
            for (int t = 0; t + 3 <= NK - 2; t += 3) {
                XG_STEP(t, pb0, pa2, pb1, pa1);
                if (!UP && t == 0) rw_ = RW[ras_];
                XG_STEP(t + 1, pb1, pa0, pb2, pa2);
                XG_STEP(t + 2, pb2, pa1, pb0, pa0);
                if (!UP && t == 0) { LAS int* ri_ = (LAS int*)(lds + 2 * XG_BUF + 2048); ri_[2 * tl] = ras_; ri_[2 * tl + 1] = __float_as_int(rw_); }
            }
            XG_STORE(pb1, pa1, ((NK - 1) & 1) * XG_BUF); __syncthreads();
            __syncthreads();
            __builtin_amdgcn_s_setprio(0);
#undef XG_ISSUE_A
#undef XG_ISSUE_B
#undef XG_STEP
#undef XG_STORE
        } else {
            const int g = lane >> 4, i = lane & 15, q4 = (lane >> 2) & 3, p4 = lane & 3;
            f32x4 acc[4][8];
#pragma unroll
            for (int mi = 0; mi < 4; ++mi)
#pragma unroll
                for (int nt = 0; nt < 8; ++nt) acc[mi][nt] = (f32x4){0.f, 0.f, 0.f, 0.f};
            LAS int* rinfo = (LAS int*)(lds + 2 * XG_BUF + 2048) + cw * 128;
#define XG_LDA(dst_, bo_, ks_) do { _Pragma("unroll") for (int mi_ = 0; mi_ < 4; ++mi_) dst_[mi_] = *(const LAS bf16x8*)(lds + (bo_) + (16 * (4 * cw + mi_) + i) * XG_AP + (32 * (ks_) + 8 * g) * 2); } while (0)
#define XG_LDB(dst_, bo_, ks_, nh_) do { _Pragma("unroll") for (int nt_ = 0; nt_ < 4; ++nt_) dst_[nt_] = cat8(tr16(lds + (bo_) + XG_ABYTES + (32 * (ks_) + 8 * g + q4) * XG_BP + (16 * (4 * (nh_) + nt_) + 4 * p4) * 2), tr16(lds + (bo_) + XG_ABYTES + (32 * (ks_) + 8 * g + 4 + q4) * XG_BP + (16 * (4 * (nh_) + nt_) + 4 * p4) * 2)); } while (0)
#define XG_MM(a_, b_, nh_) do { _Pragma("unroll") for (int mi_ = 0; mi_ < 4; ++mi_) _Pragma("unroll") for (int nt_ = 0; nt_ < 4; ++nt_) acc[mi_][4 * (nh_) + nt_] = MFMA16(a_[mi_], b_[nt_], acc[mi_][4 * (nh_) + nt_]); } while (0)
#define XG_COMPUTE(bo_) do { bf16x8 fa0_[4], fa1_[4], fb0_[4], fb1_[4]; \
                XG_LDA(fa0_, bo_, 0); XG_LDB(fb0_, bo_, 0, 0); __builtin_amdgcn_sched_barrier(0); \
                XG_LDB(fb1_, bo_, 0, 1); XG_LDA(fa1_, bo_, 1); XG_MM(fa0_, fb0_, 0); __builtin_amdgcn_sched_barrier(0); \
                XG_LDB(fb0_, bo_, 1, 0); XG_MM(fa0_, fb1_, 1); __builtin_amdgcn_sched_barrier(0); \
                XG_LDB(fb1_, bo_, 1, 1); XG_MM(fa1_, fb0_, 0); __builtin_amdgcn_sched_barrier(0); \
                XG_MM(fa1_, fb1_, 1); } while (0)
            __syncthreads();
#pragma unroll 1
            for (int t = 0; t < NK; t += 2) {
                XG_COMPUTE(0);
                __syncthreads();
                XG_COMPUTE(XG_BUF);
                __syncthreads();
            }
#undef XG_COMPUTE
#undef XG_LDA
#undef XG_LDB
#undef XG_MM
            {
                const bool odd = (i & 1) != 0;
                if (UP) {
                    LAS unsigned char* stg = lds + XG_BUF + cw * 9216;
#pragma unroll
                    for (int mi = 0; mi < 4; ++mi)
#pragma unroll
                        for (int r = 0; r < 4; ++r) { const int lrow = 16 * mi + 4 * g + r;
#pragma unroll
                            for (int q = 0; q < 2; ++q) { const float a0 = siluf(acc[mi][2 * q][r]) * acc[mi][2 * q + 4][r], a1 = siluf(acc[mi][2 * q + 1][r]) * acc[mi][2 * q + 5][r];
                                const float got = swap1(odd ? a0 : a1);
                                const unsigned pk = odd ? pk2(got, a1) : pk2(a0, got);
                                const int col = odd ? (16 * (2 * q + 1) + i - 1) : (16 * (2 * q) + i);
                                *(LAS unsigned*)(stg + lrow * 144 + col * 2) = pk; } }
#pragma unroll
                    for (int jj = 0; jj < 8; ++jj) { const int lrow = (lane >> 3) + 8 * jj, c = lane & 7, row = 64 * cw + lrow;
                        const v4u o = *(const LAS v4u*)(stg + lrow * 144 + 16 * c);
                        if (row < nrows) *(v4u*)(HG + (size_t)(off_e + rp + row) * DE + 64 * s + 8 * c) = o; }
                } else {
                    LAS unsigned char* stg = lds + XG_BUF + cw * 8704;
#pragma unroll
                    for (int h = 0; h < 2; ++h) {
#pragma unroll
                        for (int m2 = 0; m2 < 2; ++m2)
#pragma unroll
                            for (int r = 0; r < 4; ++r) { const int mi = 2 * h + m2, lrow = 16 * m2 + 4 * g + r; const float w = __int_as_float(rinfo[2 * (16 * mi + 4 * g + r) + 1]);
#pragma unroll
                                for (int q = 0; q < 4; ++q) { const float a0 = acc[mi][2 * q][r] * w, a1 = acc[mi][2 * q + 1][r] * w;
                                    const float got = swap1(odd ? a0 : a1);
                                    const unsigned pk = odd ? pk2(got, a1) : pk2(a0, got);
                                    const int col = odd ? (16 * (2 * q + 1) + i - 1) : (16 * (2 * q) + i);
                                    *(LAS unsigned*)(stg + lrow * 272 + col * 2) = pk; } }
#pragma unroll 2
                        for (int jj = 0; jj < 8; ++jj) { const int lrow = (lane >> 4) + 4 * jj, c = lane & 15, row = 64 * cw + 32 * h + lrow;
                            const v4u o = *(const LAS v4u*)(stg + lrow * 272 + 16 * c);
                            if (row < nrows) { const int as = rinfo[2 * (32 * h + lrow)]; *(v4u*)(YA + (size_t)as * D + 128 * s + 8 * c) = o; } }
                    }
                }
            }
        }
    }
}
template <bool UP>
__device__ __forceinline__ void xgemm_phase(const Args& a, LAS unsigned char* lds, int tid, int lane, int wave) {
    LAS int* cnts = (LAS int*)(lds + 2 * XG_BUF); LAS int* offs = cnts + 64; LAS int* eptab = offs + 68;
    expert_offsets((const unsigned*)(a.ws + WS_CTL) + CW_CNT, cnts, offs, eptab, XG_RM, tid);
    const int G = gridDim.x, bx = blockIdx.x; const int vcu = (G % 8 == 0) ? (bx % 8) * (G / 8) + bx / 8 : bx;
    constexpr int SH = UP ? 3 : 4;
    const int nitem = __builtin_amdgcn_readfirstlane(eptab[191]) << SH;
    for (int u = vcu; u < nitem; u += G) { const int ep = __builtin_amdgcn_readfirstlane(eptab[u >> SH]); const int e = ep & 255, rp = (ep >> 8) * XG_RM, s = u & ((1 << SH) - 1);
        xgemm_unit<UP>(a, lds, e, s, __builtin_amdgcn_readfirstlane(cnts[e]), __builtin_amdgcn_readfirstlane(offs[e]), rp, tid, lane, wave); }
}

__device__ __forceinline__ void phase11(const Args& a, int lane, int wave) {
    unsigned char* ws = a.ws;
    const float* MODF = (const float*)(ws + WS_MODF); const bf16* X1 = (const bf16*)(ws + WS_X1); const bf16* YA = (const bf16*)(ws + WS_YA); const float* g = a.in[I_GPOSTFFN];
    const int gw = blockIdx.x * NWAVES + wave, NGW = gridDim.x * NWAVES;
    v2u ya0[8], ya1[8], yb0[8], yb1[8], xa[8], xb[8];
#define P11_LOAD(y0_, y1_, x_, t_) do { _Pragma("unroll") for (int j_ = 0; j_ < 8; ++j_) { const int k_ = 4 * lane + 256 * j_; \
        y0_[j_] = *(const v2u*)(YA + (size_t)(2 * (t_)) * D + k_); y1_[j_] = *(const v2u*)(YA + (size_t)(2 * (t_) + 1) * D + k_); x_[j_] = *(const v2u*)(X1 + (size_t)(t_) * D + k_); } } while (0)
#define P11_ROW(y0_, y1_, x_, t_) do { f32x4 v_[8]; float ss_ = 0.f; \
        _Pragma("unroll") for (int j_ = 0; j_ < 8; ++j_) { const v2u p_ = y0_[j_], q_ = y1_[j_]; \
            v_[j_].x = bf2f(p_.x & 0xffffu) + bf2f(q_.x & 0xffffu); v_[j_].y = bf2f(p_.x >> 16) + bf2f(q_.x >> 16); v_[j_].z = bf2f(p_.y & 0xffffu) + bf2f(q_.y & 0xffffu); v_[j_].w = bf2f(p_.y >> 16) + bf2f(q_.y >> 16); \
            ss_ += (v_[j_].x * v_[j_].x + v_[j_].y * v_[j_].y) + (v_[j_].z * v_[j_].z + v_[j_].w * v_[j_].w); } \
        ss_ = wave_sum(ss_); const float rstd_ = 1.0f / sqrtf(ss_ * (1.0f / D) + EPS); \
        _Pragma("unroll") for (int j_ = 0; j_ < 8; ++j_) { const int k_ = 4 * lane + 256 * j_; \
            const f32x4 gv_ = *(const f32x4*)(g + k_), gt_ = *(const f32x4*)(MODF + 5 * 2048 + k_); \
            const v2u xq_ = x_[j_]; const f32x4 xv_ = {bf2f(xq_.x & 0xffffu), bf2f(xq_.x >> 16), bf2f(xq_.y & 0xffffu), bf2f(xq_.y >> 16)}; \
            *(f32x4*)(a.out + (size_t)(t_) * D + k_) = xv_ + gt_ * ((v_[j_] * rstd_) * gv_); } } while (0)
    int t = gw;
    if (t < T) P11_LOAD(ya0, ya1, xa, t);
    for (; t < T; t += 2 * NGW) {
        const int t2 = t + NGW, t3 = t + 2 * NGW;
        if (t2 < T) P11_LOAD(yb0, yb1, xb, t2);
        P11_ROW(ya0, ya1, xa, t);
        if (t2 < T) { if (t3 < T) P11_LOAD(ya0, ya1, xa, t3); P11_ROW(yb0, yb1, xb, t2); }
    }
#undef P11_LOAD
#undef P11_ROW
}

#ifndef MK_N_LAUNCHES
#define MK_N_LAUNCHES 1
#endif
constexpr int N_PHASES = 12;
constexpr int N_LAUNCHES = MK_N_LAUNCHES;
constexpr int MISC_OFF = 147456 - 256;

__global__ void __launch_bounds__(NTHR, 2) fwd_kernel(Args args) {
    extern __shared__ __attribute__((aligned(16))) unsigned char lds_raw[];
    LAS unsigned char* lds = (LAS unsigned char*)lds_raw;
    const int tid = threadIdx.x, lane = tid & 63, wave = __builtin_amdgcn_readfirstlane(tid >> 6);
    volatile LAS unsigned* MISC = (volatile LAS unsigned*)(lds + MISC_OFF);
    if (tid < 64) MISC[tid] = 0u;
    __syncthreads();
    unsigned char* ws = args.ws;
    unsigned* ctl = (unsigned*)(ws + WS_CTL);
    XcdBarrier bar; bar.bar = ctl + CW_BAR; bar.x = 0; bar.st = nullptr;
    if (N_LAUNCHES == 1) bar = xcd_barrier_post(ctl + CW_BAR, MISC + 8);
    const int lo = args.ph_lo, hi = args.ph_hi;
#ifndef ONLYP
#define ONLYP -1
#endif
#define IN(k) ((ONLYP < 0) ? (lo <= (k) && (k) < hi) : ((k) == ONLYP))
#define SEAM(k) do { if (IN(k) && IN((k) + 1)) xcd_barrier(bar); } while (0)
    if (IN(0)) { phase0<0>(args, lds, tid, lane, wave, (int)blockIdx.x * NWAVES + wave, (int)gridDim.x * NWAVES); } SEAM(0);
    if (IN(1)) { phase1(args, lds, tid, lane, wave); } SEAM(1);
    if (IN(2)) {
        pg8::Gemm g{(const pg8::bf16_t*)(ws + WS_HN), (const pg8::bf16_t*)(ws + WS_WINT), T, NIN, D};
        pg8::StaticOrder S; S.init(T, NIN, gridDim.x, (int)blockIdx.x);
        EpiIn E{(bf16*)(ws + WS_QA), (bf16*)(ws + WS_KA), (bf16*)(ws + WS_VA), (bf16*)(ws + WS_MQ0), (bf16*)(ws + WS_MK0), (bf16*)(ws + WS_MV), (bf16*)(ws + WS_MO), (const float*)(ws + WS_COS), (const float*)(ws + WS_SIN)};
        if ((int)blockIdx.x >= (int)gridDim.x - 4) gate_prep(args, lds, (int)blockIdx.x - ((int)gridDim.x - 4), tid, lane, wave);
        pg8::gemm_phase<EpiIn, pg8::StaticOrder, true, true>(lds, g, S, E);
        { const int G_ = (int)gridDim.x, rem_ = (704 % G_), first_ = (rem_ == 0) ? 0 : rem_;
          const int last_ = (G_ - 4 > first_) ? G_ - 4 : G_, nl_ = last_ - first_;
          if ((int)blockIdx.x >= first_ && (int)blockIdx.x < last_) { __syncthreads(); phase0<1>(args, lds, tid, lane, wave, ((int)blockIdx.x - first_) * NWAVES + wave, nl_ * NWAVES); } }
    } SEAM(2);
    if (IN(3)) {
        conv_phase(args, tid);
        attn_phase(args, lds, tid, lane, wave);
    } SEAM(3);
    if (IN(4)) {
        for (int it = blockIdx.x; it < 12 * (NSEG - 1); it += gridDim.x) { const int hh_ = it / (3 * (NSEG - 1)), eh_ = (it / (NSEG - 1)) % 3, sg_ = it % (NSEG - 1);
            if (eh_ == 2) mlstm_item<true, true>(args, lds, hh_, eh_, sg_, tid, lane, wave); else mlstm_item<true, false>(args, lds, hh_, eh_, sg_, tid, lane, wave); }
        { constexpr int NMA = 12 * (NSEG - 1); const int G_ = (int)gridDim.x;
          if (G_ > NMA) { if ((int)blockIdx.x >= NMA) modf_phase(args, tid, (int)blockIdx.x - NMA, G_ - NMA); } else modf_phase(args, tid, (int)blockIdx.x, G_); }
        xcd_barrier(bar);
        for (int it = blockIdx.x; it < 12 * NSEG; it += gridDim.x) { const int hh_ = it / (3 * NSEG), eh_ = (it / NSEG) % 3, sg_ = it % NSEG;
            if (eh_ == 2) mlstm_item<false, true>(args, lds, hh_, eh_, sg_, tid, lane, wave); else mlstm_item<false, false>(args, lds, hh_, eh_, sg_, tid, lane, wave); }
    } SEAM(4);
    if (IN(5)) { mlstm_norm_phase(args, lane, wave); } SEAM(5);
    if (IN(6)) {
        pg8::Gemm g{(const pg8::bf16_t*)(ws + WS_YMIX), (const pg8::bf16_t*)(ws + WS_WOUTT), T, D, D};
        pg8::StaticOrder S; S.init(T, D, gridDim.x, (int)blockIdx.x);
        EpiY E{(float*)(ws + WS_Y)};
        pg8::gemm_phase<EpiY, pg8::StaticOrder, true, true>(lds, g, S, E);
    } SEAM(6);
    if (IN(7)) { phase7(args, lds, tid, lane, wave); } if (IN(7) && IN(9)) xcd_barrier(bar);
    if (IN(9)) { xgemm_phase<true>(args, lds, tid, lane, wave); } SEAM(9);
    if (IN(10)) { xgemm_phase<false>(args, lds, tid, lane, wave); } SEAM(10);
    if (IN(11)) { phase11(args, lane, wave); }
#undef IN
#undef SEAM
}

extern "C" void kernel_launch(void* const* d_in, const int* in_sizes, int n_in, void* d_out, int out_size, void* d_ws, size_t ws_size, hipStream_t stream) {
    static int grid = 0;
    if (grid == 0) {
        if (n_in != 22 || out_size != T * D || ws_size < WS_END) { fprintf(stderr, "kernel_launch: unexpected shapes: n_in %d out %d ws %zu (need %zu)\n", n_in, out_size, ws_size, (size_t)WS_END); grid = -1; return; }
        int dev = 0, cus = 0;
        if (hipGetDevice(&dev) != hipSuccess || hipDeviceGetAttribute(&cus, hipDeviceAttributeMultiprocessorCount, dev) != hipSuccess) { grid = -1; return; }
        if (hipFuncSetAttribute((const void*)fwd_kernel, hipFuncAttributeMaxDynamicSharedMemorySize, LDS_BYTES) != hipSuccess) { fprintf(stderr, "kernel_launch: hipFuncSetAttribute failed\n"); grid = -1; return; }
        int per_cu = 0;
        if (hipOccupancyMaxActiveBlocksPerMultiprocessor(&per_cu, (const void*)fwd_kernel, NTHR, LDS_BYTES) != hipSuccess || per_cu < 1) fprintf(stderr, "kernel_launch: occupancy query says %d\n", per_cu);
        (void)hipGetLastError();
        grid = cus;
    }
    if (grid < 0) return;
    (void)hipMemsetAsync((char*)d_ws + WS_CTL, 0, CTL_ZERO_BYTES, stream);
    Args a{};
    for (int i = 0; i < 22; ++i) a.in[i] = (const float*)d_in[i];
    a.out = (float*)d_out; a.ws = (unsigned char*)d_ws;
    if (N_LAUNCHES == 1) { a.ph_lo = 0; a.ph_hi = N_PHASES; hipLaunchKernelGGL(fwd_kernel, dim3(grid), dim3(NTHR), LDS_BYTES, stream, a); }
    else for (int p = 0; p < N_PHASES; ++p) { a.ph_lo = p; a.ph_hi = p + 1; hipLaunchKernelGGL(fwd_kernel, dim3(grid), dim3(NTHR), LDS_BYTES, stream, a); }
}
```
